# Optimizing an MI355X kernel written in HIP

```python
import jax, jax.numpy as jnp
from jax import lax
import numpy as np

D_MODEL = 1024
BATCH = 1
SEQ = 16384
DEPTH = 4

N_MIXERS = 3
PLE_DIM = 256
D_FF = 2816
EPS = 1e-6
HG_HEADS = 8
HG_DK = D_MODEL // HG_HEADS
HG_DV = D_MODEL // HG_HEADS
HG_CHUNK = 64
ML_HEADS = 4
ML_DQK = D_MODEL // 2 // ML_HEADS
ML_DV = D_MODEL // ML_HEADS
ML_CHUNK = 64
ML_GATE_CAP = 15.0
SW_HEADS = 16
SW_KV_HEADS = 4
SW_GROUP = SW_HEADS // SW_KV_HEADS
SW_HD = 64
WINDOW = 128
SW_BLOCK = 128
N_A = (DEPTH + 2) // 3
N_B = (DEPTH + 1) // 3
N_C = DEPTH // 3

kernel_name = "hybrid_hgrn2_mlstm_swa_macaron"


def rmsnorm(x, gain):
    xf = x.astype(jnp.float32)
    y = xf * lax.rsqrt(jnp.mean(xf * xf, axis=-1, keepdims=True) + EPS)
    return (y * gain.astype(jnp.float32)).astype(x.dtype)


def swiglu(x, w_gu, w_down):
    g, u = jnp.split(x @ w_gu, 2, axis=-1)
    return (jax.nn.silu(g) * u) @ w_down


def to_chunks(t, L):
    B, T, H, d = t.shape
    return t.reshape(B, T // L, L, H, d).transpose(1, 0, 3, 2, 4)


def from_chunks(t):
    N, B, H, L, d = t.shape
    return t.transpose(1, 0, 3, 2, 4).reshape(B, N * L, H, d)


def gate_chunks(t, L):
    B, T, H = t.shape
    return t.reshape(B, T // L, L, H).transpose(1, 0, 3, 2)


def alibi_slopes(n_heads):
    return jnp.asarray([2.0 ** (-8.0 * (h + 1) / n_heads) for h in range(n_heads)], jnp.float32)


def hgrn2_mixer(x, lb, w_in, g_norm, w_out):
    B, T, _ = x.shape
    q, f, i, og = jnp.split(x @ w_in, 4, axis=-1)
    q = jax.nn.silu(q).astype(jnp.float32)
    f = f.astype(jnp.float32)
    lb = lb.astype(jnp.float32)
    log_f = jnp.logaddexp(jnp.log(lb), jnp.log1p(-lb) + jax.nn.log_sigmoid(f))
    k = (1.0 - lb) * jax.nn.sigmoid(-f)
    L = HG_CHUNK
    qc = to_chunks(q.reshape(B, T, HG_HEADS, HG_DK), L)
    kc = to_chunks(k.reshape(B, T, HG_HEADS, HG_DK), L)
    gc = to_chunks(log_f.reshape(B, T, HG_HEADS, HG_DK), L)
    vc = to_chunks(i.astype(jnp.float32).reshape(B, T, HG_HEADS, HG_DV), L)
    causal = jnp.tril(jnp.ones((L, L), bool))

    def step(S, inp):
        q_, k_, v_, g_ = inp
        b = jnp.cumsum(g_, axis=2)
        o_inter = jnp.einsum('bhtk,bhkv->bhtv', q_ * jnp.exp(b), S)
        diff = b[:, :, :, None, :] - b[:, :, None, :, :]
        decay = jnp.exp(jnp.where(causal[:, :, None], diff, -jnp.inf))
        A = jnp.einsum('bhtk,bhsk,bhtsk->bhts', q_, k_, decay)
        o_intra = jnp.einsum('bhts,bhsv->bhtv', A, v_)
        b_last = b[:, :, -1:, :]
        S_new = jnp.exp(b_last[:, :, 0, :])[..., None] * S + jnp.einsum(
            'bhsk,bhsv->bhkv', k_ * jnp.exp(b_last - b), v_)
        return S_new, o_inter + o_intra

    S0 = jnp.zeros((B, HG_HEADS, HG_DK, HG_DV), jnp.float32)
    _, o = lax.scan(step, S0, (qc, kc, vc, gc))
    o = rmsnorm(from_chunks(o), g_norm)
    o = o.reshape(B, T, D_MODEL).astype(x.dtype) * jax.nn.silu(og)
    return o @ w_out


def mlstm_mixer(x, w_qkvo, w_if, b_if, norm_g, w_out):
    B, T, _ = x.shape
    dqk_all = ML_HEADS * ML_DQK
    q, k, v, og = jnp.split(x @ w_qkvo, [dqk_all, 2 * dqk_all, 2 * dqk_all + D_MODEL], axis=-1)
    gates = (x @ w_if).astype(jnp.float32) + b_if.astype(jnp.float32)
    gates = ML_GATE_CAP * jnp.tanh(gates / ML_GATE_CAP)
    ig, fg = jnp.split(gates, 2, axis=-1)
    lf = jax.nn.log_sigmoid(fg)
    L = ML_CHUNK
    qc = to_chunks(q.astype(jnp.float32).reshape(B, T, ML_HEADS, ML_DQK), L)
    kc = to_chunks(k.astype(jnp.float32).reshape(B, T, ML_HEADS, ML_DQK), L) * (ML_DQK ** -0.5)
    vc = to_chunks(v.astype(jnp.float32).reshape(B, T, ML_HEADS, ML_DV), L)
    ic = gate_chunks(ig, L)
    fc = gate_chunks(lf, L)
    causal = jnp.tril(jnp.ones((L, L), bool))

    def step(carry, inp):
        C, n, m = carry
        q_, k_, v_, i_, f_ = inp
        b = jnp.cumsum(f_, axis=-1)
        log_intra = jnp.where(causal, b[..., :, None] - b[..., None, :] + i_[..., None, :], -jnp.inf)
        log_inter = b + m[..., None]
        m_t = jnp.maximum(jnp.max(log_intra, axis=-1), log_inter)
        w_intra = jnp.exp(log_intra - m_t[..., None])
        w_inter = jnp.exp(log_inter - m_t)
        scores = jnp.einsum('bhtk,bhsk->bhts', q_, k_) * w_intra
        num = w_inter[..., None] * jnp.einsum('bhtk,bhkv->bhtv', q_, C) + jnp.einsum('bhts,bhsv->bhtv', scores, v_)
        den = w_inter * jnp.einsum('bhtk,bhk->bht', q_, n) + jnp.sum(scores, axis=-1)
        h = num / jnp.maximum(jnp.abs(den), jnp.exp(-m_t))[..., None]
        b_L = b[..., -1]
        log_state = b_L + m
        log_src = b_L[..., None] - b + i_
        m_new = jnp.maximum(log_state, jnp.max(log_src, axis=-1))
        w_src = jnp.exp(log_src - m_new[..., None])
        decay = jnp.exp(log_state - m_new)
        C_new = decay[..., None, None] * C + jnp.einsum('bhsk,bhsv->bhkv', k_ * w_src[..., None], v_)
        n_new = decay[..., None] * n + jnp.einsum('bhs,bhsk->bhk', w_src, k_)
        return (C_new, n_new, m_new), h

    carry0 = (jnp.zeros((B, ML_HEADS, ML_DQK, ML_DV), jnp.float32),
              jnp.zeros((B, ML_HEADS, ML_DQK), jnp.float32),
              jnp.zeros((B, ML_HEADS), jnp.float32))
    _, h = lax.scan(step, carry0, (qc, kc, vc, ic, fc))
    h = rmsnorm(from_chunks(h), norm_g.reshape(ML_HEADS, ML_DV))
    h = h.reshape(B, T, D_MODEL).astype(x.dtype) * jax.nn.sigmoid(og)
    return h @ w_out


def swa_mixer(x, w_qkv, q_gain, k_gain, sinks, w_o):
    B, T, _ = x.shape
    nq = SW_HEADS * SW_HD
    nk = SW_KV_HEADS * SW_HD
    q, k, v = jnp.split(x @ w_qkv, [nq, nq + nk], axis=-1)
    q = rmsnorm(q.reshape(B, T, SW_HEADS, SW_HD), q_gain)
    k = rmsnorm(k.reshape(B, T, SW_KV_HEADS, SW_HD), k_gain)
    v = v.reshape(B, T, SW_KV_HEADS, SW_HD)
    nb = T // SW_BLOCK
    qb = q.reshape(B, nb, SW_BLOCK, SW_KV_HEADS, SW_GROUP, SW_HD)

    def band(t):
        tb = t.reshape(B, nb, SW_BLOCK, SW_KV_HEADS, SW_HD)
        prev = jnp.pad(tb, ((0, 0), (1, 0), (0, 0), (0, 0), (0, 0)))[:, :-1]
        return jnp.concatenate([prev, tb], axis=2)

    kk, vv = band(k), band(v)
    s = jnp.einsum('bnqkgd,bnskd->bnkgqs', qb, kk).astype(jnp.float32) * (SW_HD ** -0.5)
    qpos = jnp.arange(SW_BLOCK)
    kpos = jnp.arange(2 * SW_BLOCK) - SW_BLOCK
    dist = (qpos[:, None] - kpos[None, :]).astype(jnp.float32)
    blk_start = jnp.arange(nb) * SW_BLOCK
    valid = (dist >= 0) & (dist < WINDOW) & ((blk_start[:, None, None] + kpos[None, None, :]) >= 0)
    slopes = alibi_slopes(SW_HEADS).reshape(SW_KV_HEADS, SW_GROUP)
    s = s - slopes[:, :, None, None] * dist
    s = jnp.where(valid[None, :, None, None], s, -jnp.inf)
    sink = jnp.broadcast_to(sinks.astype(jnp.float32).reshape(SW_KV_HEADS, SW_GROUP)[:, :, None, None],
                            s.shape[:-1] + (1,))
    probs = jax.nn.softmax(jnp.concatenate([s, sink], axis=-1), axis=-1)[..., :-1]
    o = jnp.einsum('bnkgqs,bnskd->bnqkgd', probs.astype(vv.dtype), vv).reshape(B, T, nq)
    return o @ w_o


def setup_inputs(seed: int = 0) -> dict:
    key = jax.random.key(seed)
    ks = jax.random.split(key, 24)
    f32 = jnp.float32

    def nrm(k, shape, fan_in):
        return jax.random.normal(k, shape, f32) * (fan_in ** -0.5)

    D = D_MODEL
    b_if = jnp.concatenate([
        0.1 * jax.random.normal(ks[11], (N_B, ML_HEADS), f32),
        jnp.linspace(3.0, 6.0, ML_HEADS, dtype=f32)[None, :] + 0.1 * jax.random.normal(ks[12], (N_B, ML_HEADS), f32),
    ], axis=-1)
    return {
        "x": jax.random.normal(ks[0], (BATCH, SEQ, D), f32),
        "p": jax.random.normal(ks[1], (DEPTH, BATCH, SEQ, PLE_DIM), f32),
        "norm_gains": 1.0 + 0.02 * jax.random.normal(ks[2], (DEPTH, 4, D), f32),
        "w_ffn_gu": nrm(ks[3], (DEPTH, 2, D, 2 * D_FF), D),
        "w_ffn_down": nrm(ks[4], (DEPTH, 2, D_FF, D), D_FF),
        "w_ple_gate": nrm(ks[5], (DEPTH, D, D), D),
        "w_ple_proj": nrm(ks[6], (DEPTH, PLE_DIM, D), PLE_DIM),
        "hg_lower_bounds": 0.5 * jax.random.normal(ks[7], (DEPTH, D), f32),
        "hg_w_in": nrm(ks[8], (N_A, D, 4 * D), D),
        "hg_g_norm": 1.0 + 0.02 * jax.random.normal(ks[9], (N_A, HG_DV), f32),
        "hg_w_out": nrm(ks[10], (N_A, D, D), D),
        "ml_w_qkvo": nrm(ks[13], (N_B, D, 2 * ML_HEADS * ML_DQK + 2 * D), D),
        "ml_w_if": nrm(ks[14], (N_B, D, 2 * ML_HEADS), D),
        "ml_b_if": b_if,
        "ml_norm": 1.0 + 0.02 * jax.random.normal(ks[15], (N_B, D), f32),
        "ml_w_out": nrm(ks[16], (N_B, D, D), D),
        "sw_w_qkv": nrm(ks[17], (N_C, D, (SW_HEADS + 2 * SW_KV_HEADS) * SW_HD), D),
        "sw_q_norm": 1.0 + 0.02 * jax.random.normal(ks[18], (N_C, SW_HD), f32),
        "sw_k_norm": 1.0 + 0.02 * jax.random.normal(ks[19], (N_C, SW_HD), f32),
        "sw_sinks": 0.5 * jax.random.normal(ks[20], (N_C, SW_HEADS), f32),
        "sw_w_o": nrm(ks[21], (N_C, SW_HEADS * SW_HD, D), SW_HEADS * SW_HD),
    }


def reference(x, p, norm_gains, w_ffn_gu, w_ffn_down, w_ple_gate, w_ple_proj,
              hg_lower_bounds, hg_w_in, hg_g_norm, hg_w_out,
              ml_w_qkvo, ml_w_if, ml_b_if, ml_norm, ml_w_out,
              sw_w_qkv, sw_q_norm, sw_k_norm, sw_sinks, sw_w_o):
    lbs = jnp.cumsum(jax.nn.softmax(hg_lower_bounds.astype(jnp.float32), axis=0), axis=0)
    lbs = lbs - lbs[0:1]
    for layer in range(DEPTH):
        g = norm_gains[layer]
        h = x + 0.5 * swiglu(rmsnorm(x, g[0]), w_ffn_gu[layer, 0], w_ffn_down[layer, 0])
        xn = rmsnorm(h, g[1])
        kind = layer % N_MIXERS
        j = layer // N_MIXERS
        if kind == 0:
            mix = hgrn2_mixer(xn, lbs[layer], hg_w_in[j], hg_g_norm[j], hg_w_out[j])
        elif kind == 1:
            mix = mlstm_mixer(xn, ml_w_qkvo[j], ml_w_if[j], ml_b_if[j], ml_norm[j], ml_w_out[j])
        else:
            mix = swa_mixer(xn, sw_w_qkv[j], sw_q_norm[j], sw_k_norm[j], sw_sinks[j], sw_w_o[j])
        h = h + mix
        h = h + 0.5 * swiglu(rmsnorm(h, g[2]), w_ffn_gu[layer, 1], w_ffn_down[layer, 1])
        gate = jax.nn.sigmoid(rmsnorm(h, g[3]) @ w_ple_gate[layer])
        x = h + gate * (p[layer] @ w_ple_proj[layer])
    return x
```

```cpp
#include <hip/hip_runtime.h>
#include <hip/hip_cooperative_groups.h>
#include <cstdio>
#include <cstdint>
namespace cg = cooperative_groups;
namespace pg8 {
#define PG8_LAS __attribute__((address_space(3)))
typedef unsigned short bf16_t;
typedef short bf16x8 __attribute__((ext_vector_type(8)));
typedef float f32x4 __attribute__((ext_vector_type(4)));
typedef unsigned u32x4 __attribute__((ext_vector_type(4)));
constexpr int BM = 256, BK = 64, HALF = 128, HTB = HALF * BK * 2  , STAGE_BYTES = 8 * HTB, NXCD = 8, WGM = 2;

__host__ __device__ __forceinline__ int lds_byte(int r, int c) { const int st = (r >> 4) * 2 + (c >> 5), rr = r & 15, cc = c & 31, ob = rr * 64 + cc * 2; return st * 1024 + (ob ^ (((ob >> 9) & 1) << 5)); }
__host__ __device__ __forceinline__ void stage_rc(int b, int& R, int& C) { const int st = b / 1024, sb = b % 1024, swz = sb ^ (((sb >> 9) & 1) << 5); R = (st >> 1) * 16 + swz / 64; C = (st & 1) * 32 + (swz % 64) / 2; }
__host__ __device__ __forceinline__ int perm32(int rho) { const int n = rho >> 4, i = rho & 15; return 8 * (i >> 2) + 4 * n + (i & 3); }

struct Unit { int pm, pn; };
struct Gemm { const bf16_t* A; const bf16_t* Bt; int M, N, K; };

struct StaticOrder {
    int nM, nN, nwg, G, c;
    __host__ __device__ void init(int M, int N, int G_, int c_) { nM = M / BM; nN = N / BM; nwg = nM * nN; G = G_; c = c_; }
    __host__ __device__ bool next(int i, Unit& u) const {
        const long L = (long)i * G + c; if (L >= nwg) return false;
        int wgid = (int)L; { const int q = nwg / NXCD, r = nwg % NXCD, xcd = wgid % NXCD, off = wgid / NXCD; wgid = (xcd < r ? xcd * (q + 1) : r * (q + 1) + (xcd - r) * q) + off; }
        const int nig = WGM * nN, gid = wgid / nig, fm = gid * WGM, gsz = (nM - fm) < WGM ? (nM - fm) : WGM;
        u.pm = fm + ((wgid % nig) % gsz); u.pn = (wgid % nig) / gsz; return true;
    }
    __device__ __forceinline__ void a_ready(const Unit&) const {}
    __device__ __forceinline__ void done(const Unit&) const {}
};

__device__ __forceinline__ unsigned cvt_pk_bf16(float lo, float hi) { unsigned r; asm volatile("v_cvt_pk_bf16_f32 %0, %1, %2" : "=v"(r) : "v"(lo), "v"(hi)); return r; }
typedef float f32x2 __attribute__((ext_vector_type(2)));
template <class Epi, class Sched, bool ALIGN_EPI = false, bool SP2 = false>
__device__ __forceinline__ void gemm_phase(PG8_LAS unsigned char* lds, const Gemm g, const Sched& S, const Epi& E) {
    int tid_l = threadIdx.x; asm volatile("" : "+v"(tid_l));
    const int tid = tid_l, wid = __builtin_amdgcn_readfirstlane(tid >> 6), lane = tid & 63, wr = wid >> 2, wc = wid & 3, fr = lane & 15, fq = lane >> 4;
    const int K = g.K, nt = K / BK;
    unsigned voffA[2], voffB[2];
#pragma unroll
    for (int i = 0; i < 2; ++i) { int R, C; stage_rc(tid * 16 + i * 8192, R, C); const int Rb = Epi::PERM ? ((R & ~31) + perm32(R & 31)) : R;
        voffA[i] = (unsigned)(R * K + C) * 2u; voffB[i] = (unsigned)(Rb * K + C) * 2u; }
    const size_t kstep = (size_t)(BK * 2);
    const size_t hstep = (size_t)HALF * K * 2;
    const size_t tstep = 2 * hstep;
    const unsigned ldsw = (unsigned)wid * 1024u;
    const int aoff = lds_byte(wr * 64 + fr, fq * 8), boff = lds_byte(wc * 32 + fr, fq * 8);
#define PG8_SA(b, h) (((b) * 2 + (h)) * HTB)
#define PG8_SB(b, h) ((4 + (b) * 2 + (h)) * HTB)
#define PG8_STAGE(bufoff, gbase, voff) do { _Pragma("unroll") for (int _i = 0; _i < 2; ++_i) \
        __builtin_amdgcn_global_load_lds((const unsigned*)((const char*)(gbase) + (voff)[_i]), (PG8_LAS unsigned*)(lds + (bufoff) + ldsw + _i * 8192), 16, 0, 0); } while (0)
#define PG8_LDA(dst, b, h) do { _Pragma("unroll") for (int m = 0; m < 4; ++m) _Pragma("unroll") for (int k = 0; k < 2; ++k) dst[m][k] = *(const PG8_LAS bf16x8*)(lds + PG8_SA(b, h) + aoff + m * 2048 + k * 1024); } while (0)
#define PG8_LDB(dst, b, h) do { _Pragma("unroll") for (int n = 0; n < 2; ++n) _Pragma("unroll") for (int k = 0; k < 2; ++k) dst[n][k] = *(const PG8_LAS bf16x8*)(lds + PG8_SB(b, h) + boff + n * 2048 + k * 1024); } while (0)
#define PG8_MMA(ai, bj, At, Bt) do { __builtin_amdgcn_s_setprio(1); _Pragma("unroll") for (int m = 0; m < 4; ++m) _Pragma("unroll") for (int n = 0; n < 2; ++n) _Pragma("unroll") for (int k = 0; k < 2; ++k) \
        acc[ai][bj][m][n] = __builtin_amdgcn_mfma_f32_16x16x32_bf16(Bt[n][k], At[m][k], acc[ai][bj][m][n], 0, 0, 0); __builtin_amdgcn_s_setprio(0); } while (0)
#define PG8_WAIT_V(n) asm volatile("s_waitcnt vmcnt(" #n ")" ::: "memory")
#define PG8_WAIT_L(n) asm volatile("s_waitcnt lgkmcnt(" #n ")" ::: "memory")
#define PG8_BAR __builtin_amdgcn_s_barrier()
#define PG8_SCHED __builtin_amdgcn_sched_barrier(0)
    Unit cur, nxt; int ui = 0; float epre[8];
    if (!S.next(0, cur)) return;
    f32x4 acc[2][2][4][2];
#pragma unroll
    for (int a = 0; a < 2; ++a)
#pragma unroll
        for (int b = 0; b < 2; ++b)
#pragma unroll
            for (int m = 0; m < 4; ++m)
#pragma unroll
                for (int n = 0; n < 2; ++n) acc[a][b][m][n] = (f32x4){0.f, 0.f, 0.f, 0.f};
    bf16x8 At[4][2], B0[2][2], B1[2][2];
    const char* cA = (const char*)g.A + (size_t)cur.pm * tstep; const char* cB = (const char*)g.Bt + (size_t)cur.pn * tstep;
    S.a_ready(cur);
    if constexpr (SP2) {
        PG8_STAGE(PG8_SB(0, 0), cB, voffB); PG8_STAGE(PG8_SB(0, 1), cB + hstep, voffB); PG8_STAGE(PG8_SA(0, 0), cA, voffA); PG8_STAGE(PG8_SA(0, 1), cA + hstep, voffA);
        if (wr == 1) PG8_BAR;
        PG8_WAIT_V(2); PG8_BAR;
        PG8_STAGE(PG8_SB(1, 0), cB + kstep, voffB); PG8_STAGE(PG8_SA(1, 0), cA + kstep, voffA); PG8_STAGE(PG8_SB(1, 1), cB + hstep + kstep, voffB);
        PG8_WAIT_V(6); PG8_BAR;
    } else {
        PG8_STAGE(PG8_SB(0, 0), cB, voffB); PG8_STAGE(PG8_SA(0, 0), cA, voffA); PG8_STAGE(PG8_SB(0, 1), cB + hstep, voffB); PG8_STAGE(PG8_SA(0, 1), cA + hstep, voffA);
        if (wr == 1) PG8_BAR;
        PG8_WAIT_V(4); PG8_BAR;
        PG8_STAGE(PG8_SB(1, 0), cB + kstep, voffB); PG8_STAGE(PG8_SA(1, 0), cA + kstep, voffA); PG8_STAGE(PG8_SB(1, 1), cB + hstep + kstep, voffB);
        PG8_WAIT_V(6); PG8_BAR;
    }
    for (;;) {
        const bool has_next = S.next(ui + 1, nxt);
        const char* nA = has_next ? (const char*)g.A + (size_t)nxt.pm * tstep : cA; const char* nB = has_next ? (const char*)g.Bt + (size_t)nxt.pn * tstep : cB;
        for (int t = 0; t < nt; t += 2) {
            const bool last = (t == nt - 2);
            const char* a1 = cA + (size_t)(t + 1) * kstep;
            const char* a2 = last ? nA : cA + (size_t)(t + 2) * kstep; const char* b2 = last ? nB : cB + (size_t)(t + 2) * kstep;
            const char* a3 = a2 + kstep; const char* b3 = b2 + kstep;
            if (last && has_next) S.a_ready(nxt);
            if (last) E.prefetch(cur, wr, fr, epre);
            if constexpr (SP2) {
            PG8_LDB(B0, 0, 0); PG8_LDB(B1, 0, 1); PG8_SCHED; PG8_LDA(At, 0, 0); PG8_STAGE(PG8_SA(1, 1), a1 + hstep, voffA);
            PG8_WAIT_V(8); PG8_WAIT_L(0); PG8_BAR; PG8_MMA(0, 0, At, B0); PG8_MMA(0, 1, At, B1); PG8_BAR; PG8_SCHED;
            PG8_LDA(At, 0, 1); PG8_STAGE(PG8_SB(0, 0), b2, voffB); PG8_STAGE(PG8_SB(0, 1), b2 + hstep, voffB); PG8_STAGE(PG8_SA(0, 0), a2, voffA);
            PG8_WAIT_V(8); PG8_WAIT_L(0); PG8_BAR; PG8_MMA(1, 0, At, B0); PG8_MMA(1, 1, At, B1); PG8_BAR; PG8_SCHED;
            PG8_LDB(B0, 1, 0); PG8_LDB(B1, 1, 1); PG8_SCHED; PG8_LDA(At, 1, 0); PG8_STAGE(PG8_SA(0, 1), a2 + hstep, voffA);
            PG8_WAIT_V(8); PG8_WAIT_L(0); PG8_BAR; PG8_MMA(0, 0, At, B0); PG8_MMA(0, 1, At, B1); PG8_BAR; PG8_SCHED;
            PG8_LDA(At, 1, 1); PG8_STAGE(PG8_SB(1, 0), b3, voffB); PG8_STAGE(PG8_SB(1, 1), b3 + hstep, voffB); PG8_STAGE(PG8_SA(1, 0), a3, voffA);
            PG8_WAIT_V(8); PG8_WAIT_L(0); PG8_BAR; PG8_MMA(1, 0, At, B0); PG8_MMA(1, 1, At, B1); PG8_BAR; PG8_SCHED;
            } else {
            PG8_LDB(B0, 0, 0); PG8_SCHED; PG8_LDA(At, 0, 0); PG8_STAGE(PG8_SA(1, 1), a1 + hstep, voffA);
            PG8_WAIT_L(8); PG8_BAR; PG8_WAIT_L(0); PG8_MMA(0, 0, At, B0); PG8_BAR; PG8_SCHED;
            PG8_LDB(B1, 0, 1); PG8_STAGE(PG8_SB(0, 0), b2, voffB);
            PG8_BAR; PG8_WAIT_L(0); PG8_MMA(0, 1, At, B1); PG8_BAR;
            PG8_LDA(At, 0, 1); PG8_STAGE(PG8_SA(0, 0), a2, voffA);
            PG8_BAR; PG8_WAIT_L(0); PG8_MMA(1, 0, At, B0); PG8_BAR; PG8_SCHED;
            PG8_STAGE(PG8_SB(0, 1), b2 + hstep, voffB);
            PG8_WAIT_V(6); PG8_BAR; PG8_MMA(1, 1, At, B1); PG8_BAR;
            PG8_LDB(B0, 1, 0); PG8_SCHED; PG8_LDA(At, 1, 0); PG8_STAGE(PG8_SA(0, 1), a2 + hstep, voffA);
            PG8_WAIT_L(8); PG8_BAR; PG8_WAIT_L(0); PG8_MMA(0, 0, At, B0); PG8_BAR; PG8_SCHED;
            PG8_LDB(B1, 1, 1); PG8_STAGE(PG8_SB(1, 0), b3, voffB);
            PG8_BAR; PG8_WAIT_L(0); PG8_MMA(0, 1, At, B1); PG8_BAR;
            PG8_LDA(At, 1, 1); PG8_STAGE(PG8_SA(1, 0), a3, voffA);
            PG8_BAR; PG8_WAIT_L(0); PG8_MMA(1, 0, At, B0); PG8_BAR; PG8_SCHED;
            PG8_STAGE(PG8_SB(1, 1), b3 + hstep, voffB);
            PG8_WAIT_V(6); PG8_BAR; PG8_MMA(1, 1, At, B1); PG8_BAR;
            }
        }
        if constexpr (ALIGN_EPI) { if (wr == 0) PG8_BAR; }
        if constexpr (!Epi::AFTER_DRAIN) { E(acc, cur, wr, wc, fr, fq, epre); S.done(cur); }
        if (!has_next) break;
#pragma unroll
        for (int a = 0; a < 2; ++a)
#pragma unroll
            for (int b = 0; b < 2; ++b)
#pragma unroll
                for (int m = 0; m < 4; ++m)
#pragma unroll
                    for (int n = 0; n < 2; ++n) acc[a][b][m][n] = (f32x4){0.f, 0.f, 0.f, 0.f};
        cur = nxt; cA = nA; cB = nB; ++ui;
        if constexpr (ALIGN_EPI) { if (wr == 1) PG8_BAR; }
    }
    PG8_WAIT_V(0);
    if constexpr (!ALIGN_EPI) { if (wr == 0) PG8_BAR; }
    PG8_BAR;
    if constexpr (Epi::AFTER_DRAIN) { E.fused(acc, cur, wr, wc, fr, fq, lds, wid, lane); S.done(cur); }
#undef PG8_SA
#undef PG8_SB
#undef PG8_STAGE
#undef PG8_LDA
#undef PG8_LDB
#undef PG8_MMA
#undef PG8_WAIT_V
#undef PG8_WAIT_L
#undef PG8_BAR
#undef PG8_SCHED
}
}

#define LAS __attribute__((address_space(3)))
typedef unsigned short bf16;
typedef short bf16x8 __attribute__((ext_vector_type(8)));
typedef short bf16x4 __attribute__((ext_vector_type(4)));
typedef float f32x4 __attribute__((ext_vector_type(4)));
typedef float f32x16 __attribute__((ext_vector_type(16)));
typedef unsigned u32x4 __attribute__((ext_vector_type(4)));
typedef unsigned u32x2 __attribute__((ext_vector_type(2)));

constexpr int T = 16384, D = 1024, FF = 2816, PLE_DIM = 256;
constexpr float EPS = 1e-6f;
constexpr int NTHR = 512;
constexpr int LDS_BYTES = 155648;
constexpr int NPHASE = 39;
constexpr int LDS_BARST = LDS_BYTES - 64;
constexpr size_t MiB = (size_t)1 << 20;
constexpr size_t WS_SS = 598 * MiB, SS_ZERO_BYTES = 4 * MiB;
typedef long long ss_t;
constexpr size_t WS_BAR = WS_SS + 3 * MiB;
constexpr float SS_SCALE = 1048576.0f, SS_INV = 1.0f / (1024.0f * 1048576.0f);
constexpr size_t WS_WGU = 2 * MiB, WS_WDN = 90 * MiB, WS_WPG = 134 * MiB, WS_WPP = 142 * MiB, WS_HGIN = 144 * MiB, WS_HGOUT = 160 * MiB;
constexpr size_t WS_MLIN = 164 * MiB, WS_MLOUT = 170 * MiB, WS_SWIN = 172 * MiB, WS_SWOUT = 175 * MiB, WS_WIF = 177 * MiB;
constexpr size_t WS_PB = 178 * MiB, WS_PP = 210 * MiB, WS_XB0 = 242 * MiB, WS_XB1 = 274 * MiB;
constexpr size_t WS_ACT = 306 * MiB, WS_PROJ = 306 * MiB, WS_MIXO = 434 * MiB, WS_STATE = 466 * MiB;
constexpr size_t WS_DEC = 594 * MiB, WS_NST = 595 * MiB, WS_GATES = 596 * MiB, WS_LB = 597 * MiB, WS_PAR = 597 * MiB + 65536, WS_END = 602 * MiB;

__device__ __forceinline__ float bf2f(unsigned v) { return __uint_as_float(v << 16); }
__device__ __forceinline__ float bflo(unsigned w) { return __uint_as_float(w << 16); }
__device__ __forceinline__ float bfhi(unsigned w) { return __uint_as_float(w & 0xffff0000u); }
__device__ __forceinline__ unsigned pk2(float lo, float hi) { return pg8::cvt_pk_bf16(lo, hi); }
__device__ __forceinline__ float sigmoidf_(float x) { return __builtin_amdgcn_rcpf(1.0f + __expf(-x)); }
__device__ __forceinline__ float siluf_(float x) { return x * sigmoidf_(x); }
__device__ __forceinline__ int crow(int reg, int hh) { return (reg & 3) + 8 * (reg >> 2) + 4 * hh; }

#define XB_TMO      128
#define XB_XCNT(j)  (256  + 64 * (j))
#define XB_XSUB(j)  (1280 + 64 * (j))
#define XB_XGEN(j)  (2304 + 64 * (j))
#define XB_TOP      3328
#define XB_TOPGEN   3392
#define XCD_BAR_WORDS 3456
#define XB_SPIN_CAP (1u << 18)

__device__ __forceinline__ unsigned xb_ld(unsigned* p)              { return __hip_atomic_load(p, __ATOMIC_RELAXED, __HIP_MEMORY_SCOPE_AGENT); }
__device__ __forceinline__ unsigned xb_add(unsigned* p, unsigned v) { return __hip_atomic_fetch_add(p, v, __ATOMIC_RELAXED, __HIP_MEMORY_SCOPE_AGENT); }
__device__ __forceinline__ unsigned xb_xcc_id() { return (unsigned)__builtin_amdgcn_s_getreg((3 << 11) | 20) & 0xFu; }
#define XB_SPIN(cond, bar) do { unsigned _sp = 0; while (cond) { __builtin_amdgcn_s_sleep(1); \
    if ((++_sp & 255u) == 0u) { if (xb_ld(&(bar)[XB_TMO])) break; if (_sp > XB_SPIN_CAP) { atomicAdd(&(bar)[XB_TMO], 1u); break; } } } } while (0)

struct XcdBarrier {
    unsigned* bar; unsigned x;
    volatile LAS unsigned* st;
};

__device__ __forceinline__ XcdBarrier xcd_barrier_post(unsigned* bar, volatile LAS unsigned* st) {
    XcdBarrier b; b.bar = bar; b.x = xb_xcc_id(); b.st = st;
    if (threadIdx.x == 0) (void)xb_add(&bar[XB_XCNT(b.x)], 1u);
    return b;
}
__device__ __forceinline__ void xcd_barrier_complete(unsigned* bar, unsigned x, unsigned& nloc, unsigned& nx) {
    const unsigned G = gridDim.x * gridDim.y * gridDim.z;
    unsigned sum, cnt, mine, sp = 0u;
    for (;;) {
        sum = 0u; cnt = 0u; mine = 0u;
#pragma unroll
        for (unsigned j = 0; j < 16; ++j) { const unsigned c = xb_ld(&bar[XB_XCNT(j)]); sum += c; cnt += (c > 0u) ? 1u : 0u; mine = (j == x) ? c : mine; }
        if (sum == G) break;
        __builtin_amdgcn_s_sleep(1);
        if ((++sp & 255u) == 0u) { if (xb_ld(&bar[XB_TMO])) break; if (sp > XB_SPIN_CAP) { atomicAdd(&bar[XB_TMO], 1u); break; } }
    }
    nloc = mine > 0u ? mine : 1u; nx = cnt > 0u ? cnt : 1u;
}

__device__ __forceinline__ void xcd_barrier(const XcdBarrier& b) {
    asm volatile("s_waitcnt vmcnt(0)" ::: "memory");
    __syncthreads();
    if (threadIdx.x == 0) {
        unsigned* bar = b.bar;
        __builtin_amdgcn_s_waitcnt(0);
        unsigned nloc = b.st[0], nx = b.st[1];
        if (nloc == 0u) { xcd_barrier_complete(bar, b.x, nloc, nx); b.st[0] = nloc; b.st[1] = nx; }
        const unsigned old = xb_add(&bar[XB_XSUB(b.x)], 1u);
        const unsigned gen = old / nloc;
        if (old + 1u == (gen + 1u) * nloc) {
            __builtin_amdgcn_fence(__ATOMIC_RELEASE, "agent");
            asm volatile("s_waitcnt vmcnt(0)" ::: "memory");
            const unsigned og = xb_add(&bar[XB_TOP], 1u);
            const unsigned tg = og / nx;
            if (og + 1u == (tg + 1u) * nx) xb_add(&bar[XB_TOPGEN], 1u);
            else XB_SPIN(xb_ld(&bar[XB_TOPGEN]) == tg, bar);
            __builtin_amdgcn_fence(__ATOMIC_ACQUIRE, "agent");
            xb_add(&bar[XB_XGEN(b.x)], 1u);
            asm volatile("s_waitcnt vmcnt(0)" ::: "memory");
        } else {
            XB_SPIN(xb_ld(&bar[XB_XGEN(b.x)]) == gen, bar);
            __builtin_amdgcn_fence(__ATOMIC_ACQUIRE, "agent");
            asm volatile("s_waitcnt vmcnt(0)" ::: "memory");
        }
    }
    __syncthreads();
}

namespace pg8 {
__device__ __forceinline__ float row_rs(const ss_t* ss, int row) { return ss ? __builtin_amdgcn_rsqf((float)ss[row] * SS_INV + 1e-6f) : 1.0f; }

struct EpiRsBf16 {
    static constexpr bool PERM = true, AFTER_DRAIN = false;
    bf16_t* O; int ldc; const ss_t* ss;
    __device__ __forceinline__ void prefetch(const Unit&, int, int, float (&)[8]) const {}
    __device__ __forceinline__ void operator()(const f32x4 (&acc)[2][2][4][2], const Unit& u, int wr, int wc, int fr, int fq, const float (&pre)[8]) const {
        const int row0 = u.pm * BM + wr * 64 + fr, col0 = u.pn * BM + wc * 32 + 8 * fq;
#pragma unroll
        for (int ai = 0; ai < 2; ++ai)
#pragma unroll
            for (int m = 0; m < 4; ++m) { const int row = row0 + ai * HALF + m * 16; const float sc = row_rs(ss, row); bf16_t* rowp = O + (size_t)row * ldc + col0;
#pragma unroll
                for (int bj = 0; bj < 2; ++bj) { const f32x4 v0 = acc[ai][bj][m][0] * sc, v1 = acc[ai][bj][m][1] * sc;
                    u32x4 w; w.x = cvt_pk_bf16(v0[0], v0[1]); w.y = cvt_pk_bf16(v0[2], v0[3]); w.z = cvt_pk_bf16(v1[0], v1[1]); w.w = cvt_pk_bf16(v1[2], v1[3]);
                    *(u32x4*)(rowp + bj * HALF) = w; } }
    }
};
struct EpiSwiGLU {
    static constexpr bool PERM = true, AFTER_DRAIN = false;
    bf16_t* O; int ldc; const ss_t* ss;
    __device__ __forceinline__ void prefetch(const Unit& u, int wr, int fr, float (&pre)[8]) const {
        const int row0 = u.pm * BM + wr * 64 + fr;
#pragma unroll
        for (int ai = 0; ai < 2; ++ai)
#pragma unroll
            for (int m = 0; m < 4; ++m) pre[ai * 4 + m] = row_rs(ss, row0 + ai * HALF + m * 16);
    }
    __device__ __forceinline__ void operator()(const f32x4 (&acc)[2][2][4][2], const Unit& u, int wr, int wc, int fr, int fq, const float (&pre)[8]) const {
        const int row0 = u.pm * BM + wr * 64 + fr, col0 = u.pn * HALF + wc * 32 + 8 * fq;
#pragma unroll
        for (int ai = 0; ai < 2; ++ai)
#pragma unroll
            for (int m = 0; m < 4; ++m) { const int row = row0 + ai * HALF + m * 16; const float sc = pre[ai * 4 + m];
                float r[8];
#pragma unroll
                for (int n = 0; n < 2; ++n)
#pragma unroll
                    for (int i = 0; i < 4; ++i) { const float g = acc[ai][0][m][n][i] * sc, uu = acc[ai][1][m][n][i] * sc;
                        r[n * 4 + i] = g * __builtin_amdgcn_rcpf(1.0f + __builtin_amdgcn_exp2f(-1.4426950408889634f * g)) * uu; }
                u32x4 w; w.x = cvt_pk_bf16(r[0], r[1]); w.y = cvt_pk_bf16(r[2], r[3]); w.z = cvt_pk_bf16(r[4], r[5]); w.w = cvt_pk_bf16(r[6], r[7]);
                *(u32x4*)(O + (size_t)row * ldc + col0) = w; }
    }
};
template <bool PLE_MODE> struct EpiResid {
    static constexpr bool PERM = true, AFTER_DRAIN = false;
    const bf16_t* base; bf16_t* xb; float* out; ss_t* ss_out; float alpha; const ss_t* ss_in; const bf16_t* pp;
    __device__ __forceinline__ void prefetch(const Unit&, int, int, float (&)[8]) const {}
    __device__ __forceinline__ void operator()(const f32x4 (&acc)[2][2][4][2], const Unit& u, int wr, int wc, int fr, int fq, const float (&pre)[8]) const {
        const int row0 = u.pm * BM + wr * 64 + fr, col0 = u.pn * BM + wc * 32 + 8 * fq;
#pragma unroll
        for (int ai = 0; ai < 2; ++ai)
#pragma unroll
            for (int m = 0; m < 4; ++m) { const int row = row0 + ai * HALF + m * 16; const size_t off = (size_t)row * 1024 + col0;
                const float sc = PLE_MODE ? row_rs(ss_in, row) : 0.f; float s = 0.f;
#pragma unroll
                for (int bj = 0; bj < 2; ++bj) { const size_t c = off + bj * HALF; const u32x4 bw = *(const u32x4*)(base + c);
                    const float b[8] = {__uint_as_float(bw.x << 16), __uint_as_float(bw.x & 0xffff0000u), __uint_as_float(bw.y << 16), __uint_as_float(bw.y & 0xffff0000u),
                                        __uint_as_float(bw.z << 16), __uint_as_float(bw.z & 0xffff0000u), __uint_as_float(bw.w << 16), __uint_as_float(bw.w & 0xffff0000u)};
                    float a[8] = {acc[ai][bj][m][0][0], acc[ai][bj][m][0][1], acc[ai][bj][m][0][2], acc[ai][bj][m][0][3], acc[ai][bj][m][1][0], acc[ai][bj][m][1][1], acc[ai][bj][m][1][2], acc[ai][bj][m][1][3]};
                    float v[8];
                    if (PLE_MODE) { const u32x4 pw = *(const u32x4*)(pp + c);
                        const float p[8] = {__uint_as_float(pw.x << 16), __uint_as_float(pw.x & 0xffff0000u), __uint_as_float(pw.y << 16), __uint_as_float(pw.y & 0xffff0000u),
                                            __uint_as_float(pw.z << 16), __uint_as_float(pw.z & 0xffff0000u), __uint_as_float(pw.w << 16), __uint_as_float(pw.w & 0xffff0000u)};
#pragma unroll
                        for (int i = 0; i < 8; ++i) v[i] = b[i] + __builtin_amdgcn_rcpf(1.0f + __expf(-a[i] * sc)) * p[i]; }
                    else {
#pragma unroll
                        for (int i = 0; i < 8; ++i) v[i] = b[i] + a[i] * alpha; }
                    u32x4 w; w.x = cvt_pk_bf16(v[0], v[1]); w.y = cvt_pk_bf16(v[2], v[3]); w.z = cvt_pk_bf16(v[4], v[5]); w.w = cvt_pk_bf16(v[6], v[7]);
                    *(u32x4*)(xb + c) = w;
                    if (out) { *(f32x4*)(out + c) = (f32x4){v[0], v[1], v[2], v[3]}; *(f32x4*)(out + c + 4) = (f32x4){v[4], v[5], v[6], v[7]}; }
#pragma unroll
                    for (int i = 0; i < 8; ++i) s += v[i] * v[i]; }
                s += __shfl_xor(s, 16); s += __shfl_xor(s, 32);
                if (fq == 0) __hip_atomic_fetch_add((unsigned long long*)(ss_out + row), (unsigned long long)(long long)(s * SS_SCALE), __ATOMIC_RELAXED, __HIP_MEMORY_SCOPE_AGENT); }
    }
};
}

template <int KS> __device__ __forceinline__ void mm32(f32x16& acc, const LAS bf16* a, int lda, const LAS bf16* b, int ldb, int lane) {
    const int r = lane & 31, hh = lane >> 5;
    const LAS bf16* ap = a + r * lda + 8 * hh; const LAS bf16* bp = b + r * ldb + 8 * hh;
#pragma unroll
    for (int ks = 0; ks < KS; ++ks) { const bf16x8 af = *(const LAS bf16x8*)(ap + 16 * ks); const bf16x8 bfr = *(const LAS bf16x8*)(bp + 16 * ks);
        acc = __builtin_amdgcn_mfma_f32_32x32x16_bf16(af, bfr, acc, 0, 0, 0); }
}
__device__ __forceinline__ void mm_accop(f32x16& acc, const LAS bf16* vrow, const f32x16& P, int ss, int hh) {
    bf16x8 pf; u32x4 pw;
    pw.x = pk2(P[8 * ss + 0], P[8 * ss + 1]); pw.y = pk2(P[8 * ss + 2], P[8 * ss + 3]); pw.z = pk2(P[8 * ss + 4], P[8 * ss + 5]); pw.w = pk2(P[8 * ss + 6], P[8 * ss + 7]);
    pf = __builtin_bit_cast(bf16x8, pw);
    const bf16x4 v0 = *(const LAS bf16x4*)(vrow + 16 * ss + 4 * hh), v1 = *(const LAS bf16x4*)(vrow + 16 * ss + 8 + 4 * hh);
    bf16x8 vf; vf[0] = v0[0]; vf[1] = v0[1]; vf[2] = v0[2]; vf[3] = v0[3]; vf[4] = v1[0]; vf[5] = v1[1]; vf[6] = v1[2]; vf[7] = v1[3];
    acc = __builtin_amdgcn_mfma_f32_32x32x16_bf16(vf, pf, acc, 0, 0, 0);
}
#define ZERO16(x) do { _Pragma("unroll") for (int _z = 0; _z < 16; ++_z) (x)[_z] = 0.f; } while (0)

struct Args { const float* in[21]; float* out; unsigned char* ws; int ph_lo, ph_hi; };

__device__ __forceinline__ void conv_item(const float* W, int ldw, int K, int N, const float* gain, bf16* WT, int swiglu, int item, LAS float* scr, int lane) {
    const int nblk = N / 32, kb = item / nblk, nb = item - kb * nblk, k0 = 64 * kb, n0 = 32 * nb;
    int drow0 = n0;
    if (swiglu) { drow0 = (n0 < FF) ? (256 * (n0 / 128) + (n0 % 128)) : (256 * ((n0 - FF) / 128) + 128 + ((n0 - FF) % 128)); }
    { float wv[32]; const float* wp = W + (size_t)(k0 + (lane >> 5)) * ldw + n0 + (lane & 31); const float gl = gain ? gain[k0 + lane] : 1.0f;
#pragma unroll
      for (int i = 0; i < 32; ++i) wv[i] = __builtin_nontemporal_load(wp + (size_t)(2 * i) * ldw);
#pragma unroll
      for (int i = 0; i < 32; ++i) { const float g = __shfl(gl, 2 * i + (lane >> 5)); scr[(2 * i + (lane >> 5)) * 33 + (lane & 31)] = wv[i] * g; } }
    asm volatile("s_waitcnt lgkmcnt(0)" ::: "memory");
    const int c = lane & 7;
#pragma unroll
    for (int j = 0; j < 4; ++j) { const int n = (lane >> 3) + 8 * j; const LAS float* s = scr + (8 * c) * 33 + n;
        u32x4 o; o.x = pk2(s[0 * 33], s[1 * 33]); o.y = pk2(s[2 * 33], s[3 * 33]); o.z = pk2(s[4 * 33], s[5 * 33]); o.w = pk2(s[6 * 33], s[7 * 33]);
        *(u32x4*)(WT + (size_t)(drow0 + n) * K + k0 + 8 * c) = o; }
    asm volatile("s_waitcnt lgkmcnt(0)" ::: "memory");
}

__device__ __forceinline__ void prologue(const Args& a, LAS unsigned char* lds, int tid, int G) {
    const int lane = tid & 63, w = tid >> 6;
    unsigned char* ws = a.ws;
    LAS float* scr = (LAS float*)(lds + w * 16384);
    const int gw = blockIdx.x * 8 + w, NGW = G * 8;
    const float* ng = a.in[2];
    constexpr int I_GU = 16 * 176, I_DN = 44 * 32, I_PG = 16 * 32, I_PP = 4 * 32, I_HGIN = 16 * 128, I_SQ = 16 * 32, I_MLIN = 16 * 96, I_SWIN = 16 * 48;
    constexpr int NITEMS = 8 * I_GU + 8 * I_DN + 4 * I_PG + 4 * I_PP + 2 * I_HGIN + 2 * I_SQ + I_MLIN + I_SQ + I_SWIN + I_SQ;
    for (int it = gw; it < NITEMS; it += NGW) {
        int r = it;
        if (r < 8 * I_GU) { const int b = r / I_GU; r -= b * I_GU; conv_item(a.in[3] + (size_t)b * D * 2 * FF, 2 * FF, D, 2 * FF, ng + ((b >> 1) * 4 + (b & 1) * 2) * D, (bf16*)(ws + WS_WGU) + (size_t)b * 2 * FF * D, 1, r, scr, lane); continue; } r -= 8 * I_GU;
        if (r < 8 * I_DN) { const int b = r / I_DN; r -= b * I_DN; conv_item(a.in[4] + (size_t)b * FF * D, D, FF, D, nullptr, (bf16*)(ws + WS_WDN) + (size_t)b * D * FF, 0, r, scr, lane); continue; } r -= 8 * I_DN;
        if (r < 4 * I_PG) { const int b = r / I_PG; r -= b * I_PG; conv_item(a.in[5] + (size_t)b * D * D, D, D, D, ng + (b * 4 + 3) * D, (bf16*)(ws + WS_WPG) + (size_t)b * D * D, 0, r, scr, lane); continue; } r -= 4 * I_PG;
        if (r < 4 * I_PP) { const int b = r / I_PP; r -= b * I_PP; conv_item(a.in[6] + (size_t)b * PLE_DIM * D, D, PLE_DIM, D, nullptr, (bf16*)(ws + WS_WPP) + (size_t)b * D * PLE_DIM, 0, r, scr, lane); continue; } r -= 4 * I_PP;
        if (r < 2 * I_HGIN) { const int b = r / I_HGIN; r -= b * I_HGIN; conv_item(a.in[8] + (size_t)b * D * 4 * D, 4 * D, D, 4 * D, ng + (b * 3 * 4 + 1) * D, (bf16*)(ws + WS_HGIN) + (size_t)b * 4 * D * D, 0, r, scr, lane); continue; } r -= 2 * I_HGIN;
        if (r < 2 * I_SQ) { const int b = r / I_SQ; r -= b * I_SQ; conv_item(a.in[10] + (size_t)b * D * D, D, D, D, nullptr, (bf16*)(ws + WS_HGOUT) + (size_t)b * D * D, 0, r, scr, lane); continue; } r -= 2 * I_SQ;
        if (r < I_MLIN) { conv_item(a.in[11], 3 * D, D, 3 * D, ng + (1 * 4 + 1) * D, (bf16*)(ws + WS_MLIN), 0, r, scr, lane); continue; } r -= I_MLIN;
        if (r < I_SQ) { conv_item(a.in[15], D, D, D, nullptr, (bf16*)(ws + WS_MLOUT), 0, r, scr, lane); continue; } r -= I_SQ;
        if (r < I_SWIN) { conv_item(a.in[16], 1536, D, 1536, ng + (2 * 4 + 1) * D, (bf16*)(ws + WS_SWIN), 0, r, scr, lane); continue; } r -= I_SWIN;
        conv_item(a.in[20], D, D, D, nullptr, (bf16*)(ws + WS_SWOUT), 0, r, scr, lane);
    }
    { u32x4* z = (u32x4*)(ws + WS_SS + (size_t)T * 8); const int nz = 16 * T * 8 / 16;
      for (int i = blockIdx.x * NTHR + tid; i < nz; i += G * NTHR) z[i] = (u32x4){0u, 0u, 0u, 0u}; }
    { const f32x4* p4 = (const f32x4*)a.in[1]; u32x4* o4 = (u32x4*)(ws + WS_PB); const int n8 = 4 * T * PLE_DIM / 8;
#pragma unroll 4
      for (int i = blockIdx.x * NTHR + tid; i < n8; i += G * NTHR) { const f32x4 v0 = __builtin_nontemporal_load(p4 + 2 * i), v1 = __builtin_nontemporal_load(p4 + 2 * i + 1);
          u32x4 o; o.x = pk2(v0[0], v0[1]); o.y = pk2(v0[2], v0[3]); o.z = pk2(v1[0], v1[1]); o.w = pk2(v1[2], v1[3]); o4[i] = o; } }
    { ss_t* ss0 = (ss_t*)(ws + WS_SS); bf16* xb = (bf16*)(ws + WS_XB0);
      for (int m = gw; m < T; m += NGW) { const f32x4* xr = (const f32x4*)(a.in[0] + (size_t)m * D) + lane; u32x2* o = (u32x2*)(xb + (size_t)m * D) + lane; float s = 0.f;
#pragma unroll
          for (int j = 0; j < 4; ++j) { const f32x4 v = __builtin_nontemporal_load(xr + 64 * j); s += (v[0] * v[0] + v[1] * v[1]) + (v[2] * v[2] + v[3] * v[3]); u32x2 q; q.x = pk2(v[0], v[1]); q.y = pk2(v[2], v[3]); o[64 * j] = q; }
#pragma unroll
          for (int o2 = 1; o2 < 64; o2 <<= 1) s += __shfl_xor(s, o2);
          if (lane == 0) ss0[m] = (ss_t)(s * SS_SCALE); } }
    { float* wif = (float*)(ws + WS_WIF); const float* g1 = ng + (1 * 4 + 1) * D;
      for (int i = blockIdx.x * NTHR + tid; i < D * 8; i += G * NTHR) wif[i] = a.in[12][i] * g1[i >> 3];
      float* lbo = (float*)(ws + WS_LB); const float* hl = a.in[7];
      for (int k = blockIdx.x * NTHR + tid; k < D; k += G * NTHR) { const float v0 = hl[k], v1 = hl[D + k], v2 = hl[2 * D + k], v3 = hl[3 * D + k];
          const float mx = fmaxf(fmaxf(v0, v1), fmaxf(v2, v3)); const float e0 = expf(v0 - mx), e1 = expf(v1 - mx), e2 = expf(v2 - mx), e3 = expf(v3 - mx);
          lbo[k] = 0.f; lbo[D + k] = (e1 + e2 + e3) / (e0 + e1 + e2 + e3); }
      float* par = (float*)(ws + WS_PAR);
      if (blockIdx.x == 0) { for (int i = tid; i < 256; i += NTHR) par[i] = a.in[9][i]; if (tid < 8) par[256 + tid] = a.in[13][tid];
          for (int i = tid; i < 1024; i += NTHR) par[512 + i] = a.in[14][i]; if (tid < 64) { par[1536 + tid] = a.in[17][tid]; par[1600 + tid] = a.in[18][tid]; } if (tid < 16) par[1664 + tid] = a.in[19][tid]; } }
}

__device__ __forceinline__ void hg_gate(float f, float lb, float& lf, float& kk) {
    f = fminf(fmaxf(f, -30.f), 30.f);
    const float e = __expf(-f), r = __builtin_amdgcn_rcpf(1.0f + e);
    const float fo = lb + (1.0f - lb) * r; lf = __logf(fo); kk = (1.0f - lb) * (e * r);
}
template <int CNT> __device__ __forceinline__ void stage_vt(const bf16* src  , LAS bf16* dst  , int ld, bool valid) {
#pragma unroll
    for (int q = 0; q < CNT / 8; ++q) { u32x4 v = valid ? *(const u32x4*)(src + 8 * q) : (u32x4){0u, 0u, 0u, 0u};
        LAS bf16* d = dst + (8 * q) * ld;
        d[0 * ld] = (bf16)(v.x & 0xffffu); d[1 * ld] = (bf16)(v.x >> 16); d[2 * ld] = (bf16)(v.y & 0xffffu); d[3 * ld] = (bf16)(v.y >> 16);
        d[4 * ld] = (bf16)(v.z & 0xffffu); d[5 * ld] = (bf16)(v.z >> 16); d[6 * ld] = (bf16)(v.w & 0xffffu); d[7 * ld] = (bf16)(v.w >> 16); }
}
#define LDS_BAR() do { asm volatile("s_waitcnt lgkmcnt(0)" ::: "memory"); __builtin_amdgcn_s_barrier(); asm volatile("" ::: "memory"); } while (0)
__device__ __forceinline__ void stage_vt8(u32x4 v, LAS bf16* d, int ld) {
    d[0 * ld] = (bf16)(v.x & 0xffffu); d[1 * ld] = (bf16)(v.x >> 16); d[2 * ld] = (bf16)(v.y & 0xffffu); d[3 * ld] = (bf16)(v.y >> 16);
    d[4 * ld] = (bf16)(v.z & 0xffffu); d[5 * ld] = (bf16)(v.z >> 16); d[6 * ld] = (bf16)(v.w & 0xffffu); d[7 * ld] = (bf16)(v.w >> 16);
}
__device__ __forceinline__ void hg_phaseA(LAS unsigned char* lds, const bf16* proj, const float* lbv, float* state, float* dec, int tid, int G) {
    LAS bf16* KUt = (LAS bf16*)lds;
    LAS bf16* Vt = (LAS bf16*)(lds + 18432);
    LAS float* totl = (LAS float*)(lds + 36864);
    const int lane = tid & 63, w = tid >> 6, k = tid & 127, qtr = tid >> 7, tl = lane & 31;
    const int vt = w >> 1, kt0 = (w & 1) * 2;
    for (int item = blockIdx.x; item < 256; item += G) {
        const int sc = item >> 3, hd = item & 7;
        const float lb = lbv[hd * 128 + k];
        f32x16 S0, S1; ZERO16(S0); ZERO16(S1); float btot = 0.f;
        unsigned fr[16]; u32x4 va, vb;
#define HGA_LOAD(T0) do { const bf16* fp_ = proj + (size_t)((T0) + 16 * qtr) * 4096 + 1024 + hd * 128 + k; _Pragma("unroll") for (int i = 0; i < 16; ++i) fr[i] = fp_[(size_t)i * 4096]; \
            const u32x4* vp_ = (const u32x4*)(proj + (size_t)((T0) + (tid & 63)) * 4096 + 2048 + hd * 128 + 16 * (tid >> 6)); va = vp_[0]; vb = vp_[1]; } while (0)
        HGA_LOAD(sc * 512);
#pragma unroll 1
        for (int jc = 0; jc < 8; ++jc) { const int t0 = (sc * 8 + jc) * 64;
            float c[16], kk[16];
            { float run = 0.f;
#pragma unroll
              for (int i = 0; i < 16; ++i) { float lf; hg_gate(bf2f(fr[i]), lb, lf, kk[i]); run += lf; c[i] = run; }
              totl[qtr * 128 + k] = run; }
            { LAS bf16* vd = Vt + (16 * (tid >> 6)) * 72 + (tid & 63); stage_vt8(va, vd, 72); stage_vt8(vb, vd + 8 * 72, 72); }
            if (jc < 7) HGA_LOAD(t0 + 64);
            LDS_BAR();
            float off = 0.f, tot = 0.f;
#pragma unroll
            for (int q = 0; q < 4; ++q) { const float v = totl[q * 128 + k]; if (q < qtr) off += v; tot += v; }
            btot += tot;
            { float o[16];
#pragma unroll
              for (int i = 0; i < 16; ++i) o[i] = kk[i] * __expf(tot - (off + c[i]));
              u32x4 w0, w1; w0.x = pk2(o[0], o[1]); w0.y = pk2(o[2], o[3]); w0.z = pk2(o[4], o[5]); w0.w = pk2(o[6], o[7]);
              w1.x = pk2(o[8], o[9]); w1.y = pk2(o[10], o[11]); w1.z = pk2(o[12], o[13]); w1.w = pk2(o[14], o[15]);
              LAS u32x4* d = (LAS u32x4*)(KUt + k * 72 + 16 * qtr); d[0] = w0; d[1] = w1; }
            LDS_BAR();
            { const int ka = 32 * kt0 + tl, kb = ka + 32;
              const float da = __expf((totl[ka] + totl[128 + ka]) + (totl[256 + ka] + totl[384 + ka])), db = __expf((totl[kb] + totl[128 + kb]) + (totl[256 + kb] + totl[384 + kb]));
#pragma unroll
              for (int r = 0; r < 16; ++r) { S0[r] *= da; S1[r] *= db; }
              mm32<4>(S0, Vt + (32 * vt) * 72, 72, KUt + (32 * kt0) * 72, 72, lane);
              mm32<4>(S1, Vt + (32 * vt) * 72, 72, KUt + (32 * kt0 + 32) * 72, 72, lane); }
            LDS_BAR();
        }
        { float* sp = state + (size_t)item * 16384;
#pragma unroll
          for (int r = 0; r < 16; ++r) { sp[(32 * vt + crow(r, lane >> 5)) * 128 + 32 * kt0 + tl] = S0[r]; sp[(32 * vt + crow(r, lane >> 5)) * 128 + 32 * kt0 + 32 + tl] = S1[r]; } }
        if (qtr == 0) dec[(size_t)sc * 1024 + hd * 128 + k] = __expf(btot);
    }
}
__device__ __forceinline__ void scan_phase(float* state, const float* dec, int ml, float* nst, int nsteps, int tid, int G) {
    for (int e = blockIdx.x * NTHR + tid; e < 131072; e += G * NTHR) {
        float* st = state + e; const float* dp; int dstride;
        if (ml) { dp = dec + (e >> 15); dstride = 4; } else { dp = dec + (e >> 14) * 128 + (e & 127); dstride = 1024; }
        float s = 0.f;
        for (int n0 = 0; n0 < nsteps; n0 += 16) { float u[16], d[16];
#pragma unroll
            for (int j = 0; j < 16; ++j) { u[j] = st[(size_t)(n0 + j) * 131072]; d[j] = dp[(n0 + j) * dstride]; }
#pragma unroll
            for (int j = 0; j < 16; ++j) { st[(size_t)(n0 + j) * 131072] = s; s = d[j] * s + u[j]; } }
    }
    if (ml) { const int e = blockIdx.x * NTHR + tid;
        if (e < 512) { float* st = nst + e; const float* dp = dec + (e >> 7); float s = 0.f;
            for (int n = 0; n < nsteps; ++n) { const float u = st[n * 512], d = dp[n * 4]; st[n * 512] = s; s = d * s + u; } } }
}
__device__ __forceinline__ void hg_phaseC(LAS unsigned char* lds, const bf16* proj, const float* lbv, const float* state, const float* gnorm, bf16* mixo, int tid, int G) {
    LAS bf16* QA = (LAS bf16*)lds;
    LAS bf16* KA = (LAS bf16*)(lds + 17408);
    LAS bf16* QB = (LAS bf16*)(lds + 34816);
    LAS bf16* Vt = (LAS bf16*)(lds + 52224);
    LAS bf16* Sb = (LAS bf16*)(lds + 70656);
    LAS float* totl = (LAS float*)(lds + 105472);
    LAS float* red = (LAS float*)(lds + 107520);
    LAS bf16* KUt = (LAS bf16*)(lds + 108544);
    const int lane = tid & 63, w = tid >> 6, k = tid & 127, qtr = tid >> 7, tl = lane & 31, hh = lane >> 5;
    const int svt = w >> 1, skt0 = (w & 1) * 2;
    for (int item = blockIdx.x; item < 256; item += G) {
        const int sc = item >> 3, hd = item & 7;
        const float lb = lbv[hd * 128 + k];
        f32x16 S0, S1;
        { const float* sp = state + (size_t)item * 16384;
#pragma unroll
          for (int r = 0; r < 16; ++r) { S0[r] = sp[(32 * svt + crow(r, hh)) * 128 + 32 * skt0 + tl]; S1[r] = sp[(32 * svt + crow(r, hh)) * 128 + 32 * skt0 + 32 + tl]; } }
        unsigned fr[16], qr[16]; u32x4 va, vb;
#define HGC_LOAD(T0) do { const bf16* fp_ = proj + (size_t)((T0) + 16 * qtr) * 4096 + hd * 128 + k; _Pragma("unroll") for (int i = 0; i < 16; ++i) { fr[i] = fp_[(size_t)i * 4096 + 1024]; qr[i] = fp_[(size_t)i * 4096]; } \
            const u32x4* vp_ = (const u32x4*)(proj + (size_t)((T0) + (tid & 63)) * 4096 + 2048 + hd * 128 + 16 * (tid >> 6)); va = vp_[0]; vb = vp_[1]; } while (0)
        HGC_LOAD(sc * 512);
#pragma unroll 1
        for (int jc = 0; jc < 8; ++jc) { const int t0 = (sc * 8 + jc) * 64;
            float c[16], kk[16], qv[16];
            { float run = 0.f;
#pragma unroll
              for (int i = 0; i < 16; ++i) { float lf; hg_gate(bf2f(fr[i]), lb, lf, kk[i]); run += lf; c[i] = run; qv[i] = siluf_(bf2f(qr[i])); }
              totl[qtr * 128 + k] = run; }
            { LAS bf16* vd = Vt + (16 * (tid >> 6)) * 72 + (tid & 63); stage_vt8(va, vd, 72); stage_vt8(vb, vd + 8 * 72, 72); }
            if (jc < 7) HGC_LOAD(t0 + 64);
#pragma unroll
            for (int r = 0; r < 16; r += 2) { const unsigned p0 = pk2(S0[r], S0[r + 1]), p1 = pk2(S1[r], S1[r + 1]);
                LAS bf16* d0 = Sb + (32 * svt + crow(r, hh)) * 136 + 32 * skt0 + tl;
                d0[0] = (bf16)(p0 & 0xffffu); d0[136] = (bf16)(p0 >> 16); d0[32] = (bf16)(p1 & 0xffffu); d0[136 + 32] = (bf16)(p1 >> 16); }
            LDS_BAR();
            { float off = 0.f, tot = 0.f;
#pragma unroll
              for (int q = 0; q < 4; ++q) { const float v = totl[q * 128 + k]; if (q < qtr) off += v; tot += v; }
              const float bmid = totl[k] + totl[128 + k];
              float o[16];
              const float ebm = __expf(bmid), etm = __expf(tot - bmid);
#pragma unroll
              for (int i = 0; i < 16; ++i) { const int t = 16 * qtr + i; const float b = off + c[i]; const float e1 = __expf(b - bmid), r1 = __builtin_amdgcn_rcpf(e1); const float qa = qv[i] * e1, ka = kk[i] * r1;
                  QA[t * 136 + k] = (bf16)(pk2(qa, 0.f) & 0xffffu);
                  KA[t * 136 + k] = (bf16)(pk2(ka, 0.f) & 0xffffu);
                  QB[t * 136 + k] = (bf16)(pk2(qa * ebm, 0.f) & 0xffffu);
                  o[i] = ka * etm; }
              u32x4 w0, w1; w0.x = pk2(o[0], o[1]); w0.y = pk2(o[2], o[3]); w0.z = pk2(o[4], o[5]); w0.w = pk2(o[6], o[7]);
              w1.x = pk2(o[8], o[9]); w1.y = pk2(o[10], o[11]); w1.z = pk2(o[12], o[13]); w1.w = pk2(o[14], o[15]);
              LAS u32x4* d = (LAS u32x4*)(KUt + k * 72 + 16 * qtr); d[0] = w0; d[1] = w1; }
            LDS_BAR();
            const int tb = w >> 2, vt = w & 3;
            u32x2 ogw[4];
            { const bf16* ogp = proj + (size_t)(t0 + 32 * tb + tl) * 4096 + 3072 + hd * 128 + 32 * vt + 4 * hh;
#pragma unroll
              for (int g = 0; g < 4; ++g) ogw[g] = *(const u32x2*)(ogp + 8 * g); }
            f32x16 acc; ZERO16(acc);
#pragma unroll
            for (int sb = 0; sb < 2; ++sb) { if (sb <= tb) { f32x16 P; ZERO16(P);
                mm32<8>(P, KA + (32 * sb) * 136, 136, QA + (32 * tb) * 136, 136, lane);
                if (sb == tb) {
#pragma unroll
                    for (int r = 0; r < 16; ++r) if (crow(r, hh) > tl) P[r] = 0.f; }
                const LAS bf16* vrow = Vt + (32 * vt + tl) * 72 + 32 * sb;
                mm_accop(acc, vrow, P, 0, hh); mm_accop(acc, vrow, P, 1, hh); } }
            mm32<8>(acc, Sb + (32 * vt) * 136, 136, QB + (32 * tb) * 136, 136, lane);
            float ssq = 0.f;
#pragma unroll
            for (int r = 0; r < 16; ++r) ssq += acc[r] * acc[r];
            ssq += __shfl_xor(ssq, 32);
            if (lane < 32) red[vt * 64 + 32 * tb + lane] = ssq;
            { const int ka = 32 * skt0 + tl, kb = ka + 32;
              const float da = __expf((totl[ka] + totl[128 + ka]) + (totl[256 + ka] + totl[384 + ka])), db = __expf((totl[kb] + totl[128 + kb]) + (totl[256 + kb] + totl[384 + kb]));
#pragma unroll
              for (int r = 0; r < 16; ++r) { S0[r] *= da; S1[r] *= db; }
              mm32<4>(S0, Vt + (32 * svt) * 72, 72, KUt + (32 * skt0) * 72, 72, lane);
              mm32<4>(S1, Vt + (32 * svt) * 72, 72, KUt + (32 * skt0 + 32) * 72, 72, lane); }
            LDS_BAR();
            { const int t = 32 * tb + tl; const float tot = (red[t] + red[64 + t]) + (red[128 + t] + red[192 + t]); const float rms = __builtin_amdgcn_rsqf(tot * (1.0f / 128.0f) + EPS);
              bf16* op = mixo + (size_t)(t0 + t) * 1024 + hd * 128;
#pragma unroll
              for (int g = 0; g < 4; ++g) { const int v0 = 32 * vt + 8 * g + 4 * hh; const u32x2 ow = ogw[g]; const f32x4 gn = *(const f32x4*)(gnorm + v0);
                  const float o0 = acc[4 * g + 0] * rms * gn[0] * siluf_(bflo(ow.x)), o1 = acc[4 * g + 1] * rms * gn[1] * siluf_(bfhi(ow.x));
                  const float o2 = acc[4 * g + 2] * rms * gn[2] * siluf_(bflo(ow.y)), o3 = acc[4 * g + 3] * rms * gn[3] * siluf_(bfhi(ow.y));
                  u32x2 o; o.x = pk2(o0, o1); o.y = pk2(o2, o3); *(u32x2*)(op + v0) = o; } }
            LDS_BAR();
        }
    }
}

constexpr float ML_SCALE = 0.08838834764831845f;
__device__ __forceinline__ void ml_gates(LAS unsigned char* lds, const bf16* xb, const ss_t* ss, const float* wif, const float* bif, float* gates, int tid, int G) {
    LAS float* wl = (LAS float*)lds;
    const int lane = tid & 63, w = tid >> 6;
    for (int i = tid; i < 8192; i += NTHR) wl[i] = wif[i];
    __syncthreads();
    for (int row0 = (blockIdx.x * 8 + w) * 4; row0 < T; row0 += G * 32) { float a[4][8]; unsigned xr[4][16];
#pragma unroll
        for (int r = 0; r < 4; ++r) { const bf16* xp = xb + (size_t)(row0 + r) * 1024 + lane;
#pragma unroll
            for (int i = 0; i < 16; ++i) xr[r][i] = xp[64 * i]; }
#pragma unroll
        for (int r = 0; r < 4; ++r)
#pragma unroll
            for (int j = 0; j < 8; ++j) a[r][j] = 0.f;
#pragma unroll
        for (int i = 0; i < 16; ++i) { const int kx = lane + 64 * i; const f32x4 w0 = *(const LAS f32x4*)(wl + kx * 8), w1 = *(const LAS f32x4*)(wl + kx * 8 + 4);
#pragma unroll
            for (int r = 0; r < 4; ++r) { const float xv = bf2f(xr[r][i]);
                a[r][0] += xv * w0[0]; a[r][1] += xv * w0[1]; a[r][2] += xv * w0[2]; a[r][3] += xv * w0[3]; a[r][4] += xv * w1[0]; a[r][5] += xv * w1[1]; a[r][6] += xv * w1[2]; a[r][7] += xv * w1[3]; } }
#pragma unroll
        for (int r = 0; r < 4; ++r)
#pragma unroll
            for (int j = 0; j < 8; ++j) {
#pragma unroll
                for (int o = 1; o < 64; o <<= 1) a[r][j] += __shfl_xor(a[r][j], o); }
        if (lane < 4) { const int row = row0 + lane; const float rs = 1.0f / sqrtf((float)ss[row] * SS_INV + EPS); float o[8];
#pragma unroll
            for (int j = 0; j < 8; ++j) { float g = (lane == 0 ? a[0][j] : lane == 1 ? a[1][j] : lane == 2 ? a[2][j] : a[3][j]) * rs + bif[j]; g = 15.0f * tanhf(g * (1.0f / 15.0f)); o[j] = (j < 4) ? g : -log1pf(expf(-g)); }
            f32x4* gp = (f32x4*)(gates + (size_t)row * 8); gp[0] = (f32x4){o[0], o[1], o[2], o[3]}; gp[1] = (f32x4){o[4], o[5], o[6], o[7]}; }
    }
    __syncthreads();
}
__device__ __forceinline__ void ml_phaseA(LAS unsigned char* lds, const bf16* proj, const float* gates, float* state, float* dec, float* nst, int tid, int G) {
    LAS bf16* KUt = (LAS bf16*)lds;
    LAS bf16* Vt = (LAS bf16*)(lds + 18432);
    LAS float* wsrc = (LAS float*)(lds + 55296);
    LAS float* lfv = (LAS float*)(lds + 55552);
    LAS float* bcs = (LAS float*)(lds + 55808);
    const int lane = tid & 63, w = tid >> 6, k = tid & 127, qtr = tid >> 7, tl = lane & 31;
    for (int item = blockIdx.x; item < 256; item += G) {
        const int sc = item >> 2, hd = item & 3;
        f32x16 S0, S1, S2, S3; ZERO16(S0); ZERO16(S1); ZERO16(S2); ZERO16(S3); float nrun = 0.f, btot = 0.f;
        unsigned kr[16]; u32x4 vr[4]; float lfn = 0.f, ign = 0.f;
#define MLA_LOAD(T0) do { const bf16* kp_ = proj + (size_t)((T0) + 16 * qtr) * 3072 + 512 + hd * 128 + k; _Pragma("unroll") for (int i = 0; i < 16; ++i) kr[i] = kp_[(size_t)i * 3072]; \
            const u32x4* vp_ = (const u32x4*)(proj + (size_t)((T0) + (tid & 63)) * 3072 + 1024 + hd * 256 + 32 * (tid >> 6)); vr[0] = vp_[0]; vr[1] = vp_[1]; vr[2] = vp_[2]; vr[3] = vp_[3]; \
            if (tid < 64) { lfn = gates[(size_t)((T0) + tid) * 8 + 4 + hd]; ign = gates[(size_t)((T0) + tid) * 8 + hd]; } } while (0)
        MLA_LOAD(sc * 256);
#pragma unroll 1
        for (int jc = 0; jc < 4; ++jc) { const int t0 = (sc * 4 + jc) * 64;
            const float ig = ign;
            if (tid < 64) lfv[tid] = lfn;
            { LAS bf16* vd = Vt + (32 * (tid >> 6)) * 72 + (tid & 63); stage_vt8(vr[0], vd, 72); stage_vt8(vr[1], vd + 8 * 72, 72); stage_vt8(vr[2], vd + 16 * 72, 72); stage_vt8(vr[3], vd + 24 * 72, 72); }
            unsigned kc[16];
#pragma unroll
            for (int i = 0; i < 16; ++i) kc[i] = kr[i];
            if (jc < 3) MLA_LOAD(t0 + 64);
            LDS_BAR();
            if (tid < 64) { float b = 0.f, bc = 0.f;
                for (int s = 0; s < 64; ++s) { const float v = lfv[s]; bc += v; if (s <= tid) b += v; }
                wsrc[tid] = __expf(bc - b + ig) * ML_SCALE; if (tid == 0) bcs[0] = bc; }
            LDS_BAR();
            { float o[16];
#pragma unroll
              for (int i = 0; i < 16; ++i) o[i] = bf2f(kc[i]) * wsrc[16 * qtr + i];
              u32x4 w0, w1; w0.x = pk2(o[0], o[1]); w0.y = pk2(o[2], o[3]); w0.z = pk2(o[4], o[5]); w0.w = pk2(o[6], o[7]);
              w1.x = pk2(o[8], o[9]); w1.y = pk2(o[10], o[11]); w1.z = pk2(o[12], o[13]); w1.w = pk2(o[14], o[15]);
              LAS u32x4* d = (LAS u32x4*)(KUt + k * 72 + 16 * qtr); d[0] = w0; d[1] = w1; }
            LDS_BAR();
            { const float bc = bcs[0], dd = __expf(bc); btot += bc;
#pragma unroll
              for (int r = 0; r < 16; ++r) { S0[r] *= dd; S1[r] *= dd; S2[r] *= dd; S3[r] *= dd; }
              mm32<4>(S0, Vt + (32 * w) * 72, 72, KUt, 72, lane); mm32<4>(S1, Vt + (32 * w) * 72, 72, KUt + 32 * 72, 72, lane);
              mm32<4>(S2, Vt + (32 * w) * 72, 72, KUt + 64 * 72, 72, lane); mm32<4>(S3, Vt + (32 * w) * 72, 72, KUt + 96 * 72, 72, lane);
              if (tid < 128) { float s = 0.f; const LAS bf16* kr = KUt + tid * 72;
                  for (int i = 0; i < 64; ++i) s += bf2f(kr[i]);
                  nrun = dd * nrun + s; } }
            LDS_BAR();
        }
        { float* sp = state + (size_t)item * 32768;
#pragma unroll
          for (int r = 0; r < 16; ++r) { float* rp = sp + (32 * w + crow(r, lane >> 5)) * 128 + tl; rp[0] = S0[r]; rp[32] = S1[r]; rp[64] = S2[r]; rp[96] = S3[r]; } }
        if (tid < 128) nst[(size_t)item * 128 + tid] = nrun;
        if (tid == 0) dec[item] = __expf(btot);
    }
}
__device__ __forceinline__ void ml_phaseC(LAS unsigned char* lds, const bf16* proj, const float* gates, const float* state, const float* nst, const float* normg, bf16* mixo, int tid, int G) {
    LAS bf16* Qs = (LAS bf16*)lds;
    LAS bf16* Ks = (LAS bf16*)(lds + 17408);
    LAS bf16* KUt = (LAS bf16*)lds;
    LAS bf16* Vt = (LAS bf16*)(lds + 34816);
    LAS bf16* Cb = (LAS bf16*)(lds + 71680);
    LAS float* bv = (LAS float*)(lds + 141312);
    LAS float* cv = (LAS float*)(lds + 141568);
    LAS float* npv = (LAS float*)(lds + 141824);
    LAS float* red = (LAS float*)(lds + 142336);
    LAS float* lfv = (LAS float*)(lds + 143360);
    LAS float* wsrc = (LAS float*)(lds + 143616);
    LAS float* bcs = (LAS float*)(lds + 143872);
    const int lane = tid & 63, w = tid >> 6, tl = lane & 31, hh = lane >> 5, kx = tid & 127, qtr = tid >> 7;
    for (int item = blockIdx.x; item < 256; item += G) {
        const int sc = item >> 2, hd = item & 3;
        f32x16 S0, S1, S2, S3; float nrun = 0.f;
        { const float* sp = state + (size_t)item * 32768;
#pragma unroll
          for (int r = 0; r < 16; ++r) { const float* rp = sp + (32 * w + crow(r, hh)) * 128 + tl; S0[r] = rp[0]; S1[r] = rp[32]; S2[r] = rp[64]; S3[r] = rp[96]; } }
        if (tid < 128) nrun = nst[(size_t)item * 128 + tid];
#pragma unroll 1
        for (int jc = 0; jc < 4; ++jc) { const int t0 = (sc * 4 + jc) * 64;
            float ig = 0.f;
            if (tid < 64) { lfv[tid] = gates[(size_t)(t0 + tid) * 8 + 4 + hd]; ig = gates[(size_t)(t0 + tid) * 8 + hd]; }
            if (tid < 128) npv[tid] = nrun;
#pragma unroll
            for (int it = 0; it < 2; ++it) { const int idx = it * NTHR + tid, row = idx >> 4, c8 = (idx & 15) * 8; const bf16* src = proj + (size_t)(t0 + row) * 3072 + hd * 128 + c8;
                *(LAS u32x4*)(Qs + row * 136 + c8) = *(const u32x4*)src; *(LAS u32x4*)(Ks + row * 136 + c8) = *(const u32x4*)(src + 512); }
            { const int s = tid & 63, vg = tid >> 6; stage_vt<32>(proj + (size_t)(t0 + s) * 3072 + 1024 + hd * 256 + 32 * vg, Vt + (32 * vg) * 72 + s, 72, true); }
#pragma unroll
            for (int r = 0; r < 16; r += 2) { LAS bf16* d0 = Cb + (32 * w + crow(r, hh)) * 136 + tl;
                const unsigned p0 = pk2(S0[r], S0[r + 1]), p1 = pk2(S1[r], S1[r + 1]), p2_ = pk2(S2[r], S2[r + 1]), p3 = pk2(S3[r], S3[r + 1]);
                d0[0] = (bf16)(p0 & 0xffffu); d0[136] = (bf16)(p0 >> 16); d0[32] = (bf16)(p1 & 0xffffu); d0[136 + 32] = (bf16)(p1 >> 16);
                d0[64] = (bf16)(p2_ & 0xffffu); d0[136 + 64] = (bf16)(p2_ >> 16); d0[96] = (bf16)(p3 & 0xffffu); d0[136 + 96] = (bf16)(p3 >> 16); }
            LDS_BAR();
            if (tid < 64) { float b = 0.f, bc = 0.f;
                for (int s = 0; s < 64; ++s) { const float v = lfv[s]; bc += v; if (s <= tid) b += v; }
                bv[tid] = b; cv[tid] = ig - b; wsrc[tid] = __expf(bc - b + ig) * ML_SCALE; if (tid == 0) bcs[0] = bc; }
            LDS_BAR();
            const int tb = w >> 2, vq = w & 3, t = 32 * tb + tl;
            const float bt = bv[t], ebt = __expf(bt);
            f32x16 ai0, ai1; ZERO16(ai0); ZERO16(ai1);
            mm32<8>(ai0, Cb + (64 * vq) * 136, 136, Qs + (32 * tb) * 136, 136, lane);
            mm32<8>(ai1, Cb + (64 * vq + 32) * 136, 136, Qs + (32 * tb) * 136, 136, lane);
#pragma unroll
            for (int r = 0; r < 16; ++r) { ai0[r] *= ebt; ai1[r] *= ebt; }
            float densum = 0.f;
#pragma unroll
            for (int sb = 0; sb < 2; ++sb) { if (sb <= tb) { f32x16 P; ZERO16(P);
                mm32<8>(P, Ks + (32 * sb) * 136, 136, Qs + (32 * tb) * 136, 136, lane);
#pragma unroll
                for (int r = 0; r < 16; ++r) { const int s = 32 * sb + crow(r, hh); const float wg = (s <= t) ? __expf(bt + cv[s]) : 0.f; const float v = P[r] * ML_SCALE * wg; densum += v; P[r] = v; }
                const LAS bf16* vr0 = Vt + (64 * vq + tl) * 72 + 32 * sb; const LAS bf16* vr1 = vr0 + 32 * 72;
                mm_accop(ai0, vr0, P, 0, hh); mm_accop(ai0, vr0, P, 1, hh); mm_accop(ai1, vr1, P, 0, hh); mm_accop(ai1, vr1, P, 1, hh); } }
            densum += __shfl_xor(densum, 32);
            float qn = 0.f;
            { const LAS bf16* qr = Qs + t * 136 + 64 * hh; const LAS float* np = npv + 64 * hh;
#pragma unroll 8
              for (int i = 0; i < 64; ++i) qn += bf2f(qr[i]) * np[i]; }
            qn += __shfl_xor(qn, 32);
            const float den = densum + ebt * qn; const float inv = 1.0f / fmaxf(fabsf(den), 1.0f);
            float ssq = 0.f;
#pragma unroll
            for (int r = 0; r < 16; ++r) { ai0[r] *= inv; ai1[r] *= inv; ssq += ai0[r] * ai0[r] + ai1[r] * ai1[r]; }
            ssq += __shfl_xor(ssq, 32);
            if (lane < 32) red[vq * 64 + t] = ssq;
            unsigned kraw[16];
#pragma unroll
            for (int i = 0; i < 16; ++i) kraw[i] = Ks[(16 * qtr + i) * 136 + kx];
            LDS_BAR();
            { float o[16];
#pragma unroll
              for (int i = 0; i < 16; ++i) o[i] = bf2f(kraw[i]) * wsrc[16 * qtr + i];
              u32x4 w0, w1; w0.x = pk2(o[0], o[1]); w0.y = pk2(o[2], o[3]); w0.z = pk2(o[4], o[5]); w0.w = pk2(o[6], o[7]);
              w1.x = pk2(o[8], o[9]); w1.y = pk2(o[10], o[11]); w1.z = pk2(o[12], o[13]); w1.w = pk2(o[14], o[15]);
              LAS u32x4* d = (LAS u32x4*)(KUt + kx * 72 + 16 * qtr); d[0] = w0; d[1] = w1; }
            { const float tot = (red[t] + red[64 + t]) + (red[128 + t] + red[192 + t]); const float rms = __builtin_amdgcn_rsqf(tot * (1.0f / 256.0f) + EPS);
              const bf16* ogp = proj + (size_t)(t0 + t) * 3072 + 2048 + hd * 256; bf16* op = mixo + (size_t)(t0 + t) * 1024 + hd * 256; const float* gp = normg + hd * 256;
#pragma unroll
              for (int vt2 = 0; vt2 < 2; ++vt2)
#pragma unroll
                for (int g = 0; g < 4; ++g) { const int v0 = 64 * vq + 32 * vt2 + 8 * g + 4 * hh; const u32x2 ow = *(const u32x2*)(ogp + v0); const f32x4 gn = *(const f32x4*)(gp + v0);
                  const float a0 = vt2 ? ai1[4 * g + 0] : ai0[4 * g + 0], a1 = vt2 ? ai1[4 * g + 1] : ai0[4 * g + 1], a2 = vt2 ? ai1[4 * g + 2] : ai0[4 * g + 2], a3 = vt2 ? ai1[4 * g + 3] : ai0[4 * g + 3];
                  u32x2 o; o.x = pk2(a0 * rms * gn[0] * sigmoidf_(bflo(ow.x)), a1 * rms * gn[1] * sigmoidf_(bfhi(ow.x)));
                  o.y = pk2(a2 * rms * gn[2] * sigmoidf_(bflo(ow.y)), a3 * rms * gn[3] * sigmoidf_(bfhi(ow.y))); *(u32x2*)(op + v0) = o; } }
            LDS_BAR();
            { const float dd = __expf(bcs[0]);
#pragma unroll
              for (int r = 0; r < 16; ++r) { S0[r] *= dd; S1[r] *= dd; S2[r] *= dd; S3[r] *= dd; }
              mm32<4>(S0, Vt + (32 * w) * 72, 72, KUt, 72, lane); mm32<4>(S1, Vt + (32 * w) * 72, 72, KUt + 32 * 72, 72, lane);
              mm32<4>(S2, Vt + (32 * w) * 72, 72, KUt + 64 * 72, 72, lane); mm32<4>(S3, Vt + (32 * w) * 72, 72, KUt + 96 * 72, 72, lane);
              if (tid < 128) { float s = 0.f; const LAS bf16* kr = KUt + tid * 72;
                  for (int i = 0; i < 64; ++i) s += bf2f(kr[i]);
                  nrun = dd * nrun + s; } }
            LDS_BAR();
        }
    }
}

__device__ __forceinline__ void swa_phase(LAS unsigned char* lds, const bf16* proj, const float* qg, const float* kg, const float* sinks, bf16* mixo, int tid, int G) {
    LAS bf16* Ks = (LAS bf16*)lds;
    LAS bf16* Vt = (LAS bf16*)(lds + 36864);
    LAS bf16* Qs = (LAS bf16*)(lds + 70656);
    const int lane = tid & 63, w = tid >> 6, tl = lane & 31, hh = lane >> 5;
    for (int item = blockIdx.x; item < 512; item += G) {
        const int nb = item >> 2, kvh = item & 3, tok0 = 128 * nb - 128;
        { const int c = tid & 7, r0 = tid >> 3;
          const f32x4 kg0 = *(const f32x4*)(kg + 8 * c), kg1 = *(const f32x4*)(kg + 8 * c + 4), qg0 = *(const f32x4*)(qg + 8 * c), qg1 = *(const f32x4*)(qg + 8 * c + 4);
#pragma unroll 2
          for (int pass = 0; pass < 12; ++pass) { const bool isk = pass < 4; const int row = r0 + 64 * (isk ? pass : pass - 4);
              int tok; const bf16* src;
              if (isk) { tok = tok0 + row; src = proj + (size_t)tok * 1536 + 1024 + kvh * 64 + 8 * c; }
              else { tok = 128 * nb + (row & 127); src = proj + (size_t)tok * 1536 + (kvh * 4 + (row >> 7)) * 64 + 8 * c; }
              u32x4 v = (tok >= 0) ? *(const u32x4*)src : (u32x4){0u, 0u, 0u, 0u};
              float f[8] = {bflo(v.x), bfhi(v.x), bflo(v.y), bfhi(v.y), bflo(v.z), bfhi(v.z), bflo(v.w), bfhi(v.w)};
              float ss = 0.f;
#pragma unroll
              for (int j = 0; j < 8; ++j) ss += f[j] * f[j];
              ss += __shfl_xor(ss, 1); ss += __shfl_xor(ss, 2); ss += __shfl_xor(ss, 4);
              const float r = __builtin_amdgcn_rsqf(ss * (1.0f / 64.0f) + EPS);
              const f32x4 g0 = isk ? kg0 : qg0, g1 = isk ? kg1 : qg1;
              u32x4 o; o.x = pk2(f[0] * r * g0[0], f[1] * r * g0[1]); o.y = pk2(f[2] * r * g0[2], f[3] * r * g0[3]); o.z = pk2(f[4] * r * g1[0], f[5] * r * g1[1]); o.w = pk2(f[6] * r * g1[2], f[7] * r * g1[3]);
              *(LAS u32x4*)((isk ? Ks : Qs) + row * 72 + 8 * c) = o; } }
        { const int s = tid & 255, dg = tid >> 8, tok = tok0 + s;
          stage_vt<32>(proj + (size_t)tok * 1536 + 1280 + kvh * 64 + 32 * dg, Vt + (32 * dg) * 264 + s, 264, tok >= 0); }
        LDS_BAR();
#pragma unroll 1
        for (int rep = 0; rep < 2; ++rep) { const int task = w + 8 * rep, g = task >> 2, qb = task & 3, hq = kvh * 4 + g, tq = 32 * qb + tl;
            const float slope = exp2f(-0.5f * (float)(hq + 1)), sink = sinks[hq];
            const int dbase = tl - 4 * hh; const unsigned dmax = (nb == 0) ? (unsigned)(tq + 1) : 128u;
            const LAS bf16* qrow = Qs + (g * 128 + 32 * qb) * 72; const LAS bf16* krow = Ks + (32 * qb) * 72;
            float m = sink;
#pragma unroll 1
            for (int kb = 0; kb < 5; ++kb) { f32x16 S; ZERO16(S); mm32<4>(S, krow + (32 * kb) * 72, 72, qrow, 72, lane);
                const int db = dbase + 128 - 32 * kb;
#pragma unroll
                for (int r = 0; r < 16; ++r) { const int dist = db - ((r & 3) + 8 * (r >> 2)); const float sc = S[r] * 0.125f - slope * (float)dist; if ((unsigned)dist < dmax) m = fmaxf(m, sc); } }
            m = fmaxf(m, __shfl_xor(m, 32));
            float l = 0.f; f32x16 O0, O1; ZERO16(O0); ZERO16(O1);
#pragma unroll 1
            for (int kb = 0; kb < 5; ++kb) { f32x16 S; ZERO16(S); mm32<4>(S, krow + (32 * kb) * 72, 72, qrow, 72, lane);
                const int db = dbase + 128 - 32 * kb;
#pragma unroll
                for (int r = 0; r < 16; ++r) { const int dist = db - ((r & 3) + 8 * (r >> 2)); const float sc = S[r] * 0.125f - slope * (float)dist; const float p = ((unsigned)dist < dmax) ? __expf(sc - m) : 0.f; S[r] = p; l += p; }
                const LAS bf16* vr0 = Vt + tl * 264 + 32 * qb + 32 * kb; const LAS bf16* vr1 = vr0 + 32 * 264;
                mm_accop(O0, vr0, S, 0, hh); mm_accop(O0, vr0, S, 1, hh); mm_accop(O1, vr1, S, 0, hh); mm_accop(O1, vr1, S, 1, hh); }
            l += __shfl_xor(l, 32); l += __expf(sink - m);
            const float inv = 1.0f / l; bf16* op = mixo + (size_t)(128 * nb + tq) * 1024 + hq * 64;
#pragma unroll
            for (int gq = 0; gq < 4; ++gq) { const int d0 = 8 * gq + 4 * hh; u32x2 o;
                o.x = pk2(O0[4 * gq] * inv, O0[4 * gq + 1] * inv); o.y = pk2(O0[4 * gq + 2] * inv, O0[4 * gq + 3] * inv); *(u32x2*)(op + d0) = o;
                o.x = pk2(O1[4 * gq] * inv, O1[4 * gq + 1] * inv); o.y = pk2(O1[4 * gq + 2] * inv, O1[4 * gq + 3] * inv); *(u32x2*)(op + 32 + d0) = o; } }
        LDS_BAR();
    }
}

#ifndef REP_GU
#define REP_GU 1
#endif
#ifndef REP_PRO
#define REP_PRO 1
#endif
#ifndef REP_SYNC
#define REP_SYNC 1
#endif
#ifndef REP_MIX
#define REP_MIX 1
#endif
#ifndef MK_PER_PHASE_LAUNCH
#define MK_PER_PHASE_LAUNCH 0
#endif
__global__ void __launch_bounds__(NTHR, 2) fwd(Args a) {
    extern __shared__ __attribute__((aligned(16))) unsigned char lds_raw[];
    LAS unsigned char* lds = (LAS unsigned char*)lds_raw;
    const int G0 = gridDim.x;
    if (threadIdx.x < 16) ((LAS unsigned*)(lds + LDS_BARST))[threadIdx.x] = 0u;
    __syncthreads();
    const XcdBarrier bar = xcd_barrier_post((unsigned*)(a.ws + WS_BAR), (volatile LAS unsigned*)(lds + LDS_BARST));
    const int ph_hi = a.ph_hi;
    if (a.ph_lo == 0) {
#ifndef DIS_PRO
#pragma unroll 1
        for (int rr = 0; rr < REP_PRO; ++rr) prologue(a, lds, (int)threadIdx.x, G0);
#endif
        if (1 < ph_hi) { xcd_barrier(bar); } }
    if (ph_hi < 0) cg::this_grid().sync();
    unsigned char* const ws0 = a.ws; float* const out0 = a.out;
    for (int p = (a.ph_lo > 1 ? a.ph_lo : 1); p < ph_hi; ++p) {
        int tid = threadIdx.x; asm volatile("" : "+v"(tid));
        int G = G0; asm volatile("" : "+s"(G));
        int bid = blockIdx.x; asm volatile("" : "+s"(bid));
        size_t zoff = 0; asm volatile("" : "+s"(zoff));
        unsigned char* ws = ws0 + zoff; float* OUT = out0 + zoff;
        ss_t* SS = (ss_t*)(ws + WS_SS);
        bf16* ACT = (bf16*)(ws + WS_ACT); bf16* PROJ = (bf16*)(ws + WS_PROJ); bf16* MIXO = (bf16*)(ws + WS_MIXO); bf16* PPb = (bf16*)(ws + WS_PP);
        float* STATE = (float*)(ws + WS_STATE); float* DEC = (float*)(ws + WS_DEC); float* NST = (float*)(ws + WS_NST); float* GATES = (float*)(ws + WS_GATES);
        const float* PAR = (const float*)(ws + WS_PAR);
        int layer = 0, step = 0;
        { const int q = p - 1;
            if (q < 10) { layer = 0; step = q; } else if (q < 20) { layer = 1; step = q - 10; }
            else if (q < 28) { layer = 2; step = q - 20; if (step >= 3) step = (step == 3) ? 10 : step + 2; } else { layer = 3; step = q - 28; } }
        const int kind = layer % 3, j = layer / 3;
        bf16* xb_in = (bf16*)(ws + ((layer & 1) ? WS_XB1 : WS_XB0)); bf16* xb_out = (bf16*)(ws + ((layer & 1) ? WS_XB0 : WS_XB1));
        if (step == 0 || step == 7) { const int sub = (step == 7) ? 1 : 0;
            pg8::Gemm g{xb_in, (const bf16*)(ws + WS_WGU) + (size_t)(layer * 2 + sub) * 2 * FF * D, T, 2 * FF, D}; pg8::StaticOrder S; S.init(T, 2 * FF, G, bid);
            pg8::EpiSwiGLU E{ACT, FF, SS + (size_t)(layer * 4 + sub * 2) * T};

#ifndef DIS_GU
#pragma unroll 1
 for (int rr = 0; rr < REP_GU; ++rr) pg8::gemm_phase<pg8::EpiSwiGLU, pg8::StaticOrder, true, true>(lds, g, S, E);
#endif
            if (step == 0 && G == 256 && bid >= 128) {
                pg8::Gemm g2{(const bf16*)(ws + WS_PB) + (size_t)layer * T * PLE_DIM, (const bf16*)(ws + WS_WPP) + (size_t)layer * D * PLE_DIM, T, D, PLE_DIM}; pg8::EpiRsBf16 E2{PPb, D, nullptr};
                pg8::StaticOrder S2; S2.init(T, D, 128, bid - 128);
                pg8::gemm_phase<pg8::EpiRsBf16, pg8::StaticOrder, true, true>(lds, g2, S2, E2); }
 }
        else if (step == 1 || step == 8 || step == 6) {
            pg8::Gemm g; pg8::EpiResid<false> E; E.out = nullptr; E.xb = xb_in; E.ss_in = nullptr; E.pp = nullptr; E.base = xb_in;
            if (step == 6) { const bf16* wo = (kind == 0) ? (const bf16*)(ws + WS_HGOUT) + (size_t)j * D * D : (kind == 1) ? (const bf16*)(ws + WS_MLOUT) : (const bf16*)(ws + WS_SWOUT);
                g = pg8::Gemm{MIXO, wo, T, D, D}; E.alpha = 1.0f; E.ss_out = SS + (size_t)(layer * 4 + 2) * T; }
            else { const int sub = (step == 8) ? 1 : 0; g = pg8::Gemm{ACT, (const bf16*)(ws + WS_WDN) + (size_t)(layer * 2 + sub) * D * FF, T, D, FF}; E.alpha = 0.5f;
                E.ss_out = SS + (size_t)(layer * 4 + 1 + 2 * sub) * T; }
            pg8::StaticOrder S; S.init(T, D, G, bid);

#ifndef DIS_RES
 pg8::gemm_phase<pg8::EpiResid<false>, pg8::StaticOrder, true, true>(lds, g, S, E);
#endif
 }
        else if (step == 2) {
#pragma unroll 1
            for (int rep = 0; rep < (G == 256 ? 1 : 2); ++rep) { pg8::Gemm g; pg8::EpiRsBf16 E;
                if (rep == 0) { const int N = (kind == 0) ? 4 * D : (kind == 1) ? 3 * D : 1536;
                    const bf16* wi = (kind == 0) ? (const bf16*)(ws + WS_HGIN) + (size_t)j * 4 * D * D : (kind == 1) ? (const bf16*)(ws + WS_MLIN) : (const bf16*)(ws + WS_SWIN);
                    g = pg8::Gemm{xb_in, wi, T, N, D}; E = pg8::EpiRsBf16{PROJ, N, SS + (size_t)(layer * 4 + 1) * T}; }
                else { g = pg8::Gemm{(const bf16*)(ws + WS_PB) + (size_t)layer * T * PLE_DIM, (const bf16*)(ws + WS_WPP) + (size_t)layer * D * PLE_DIM, T, D, PLE_DIM}; E = pg8::EpiRsBf16{PPb, D, nullptr}; }
                pg8::StaticOrder S; S.init(T, g.N, G, bid);

#ifndef DIS_RS
 pg8::gemm_phase<pg8::EpiRsBf16, pg8::StaticOrder, true, true>(lds, g, S, E);
#endif
 }

#ifndef DIS_GATES
 if (kind == 1) ml_gates(lds, xb_in, SS + (size_t)(layer * 4 + 1) * T, (const float*)(ws + WS_WIF), PAR + 256, GATES, tid, G);
#endif
 }
        else if (step == 3) {
#ifndef DIS_A
#pragma unroll 1
 for (int rr = 0; rr < REP_MIX; ++rr)
 if (kind == 0) hg_phaseA(lds, PROJ, (const float*)(ws + WS_LB) + j * D, STATE, DEC, tid, G); else ml_phaseA(lds, PROJ, GATES, STATE, DEC, NST, tid, G);
#endif
 }
        else if (step == 4) {
#ifndef DIS_SCAN
 scan_phase(STATE, DEC, kind == 1 ? 1 : 0, NST, kind == 1 ? 64 : 32, tid, G);
#endif
 }
        else if (step == 5) {
#ifndef DIS_HGC
#pragma unroll 1
 for (int rr = 0; rr < REP_MIX; ++rr)
 if (kind == 0) hg_phaseC(lds, PROJ, (const float*)(ws + WS_LB) + j * D, STATE, PAR + j * 128, MIXO, tid, G);
#endif
#ifndef DIS_MLC
#pragma unroll 1
 for (int rr = 0; rr < REP_MIX; ++rr)
 if (kind == 1) ml_phaseC(lds, PROJ, GATES, STATE, NST, PAR + 512, MIXO, tid, G);
#endif
 }
        else if (step == 10) {
#ifndef DIS_SWA
#pragma unroll 1
 for (int rr = 0; rr < REP_MIX; ++rr)
 swa_phase(lds, PROJ, PAR + 1536, PAR + 1600, PAR + 1664, MIXO, tid, G);
#endif
 }
        else if (step == 9) {
            pg8::Gemm g{xb_in, (const bf16*)(ws + WS_WPG) + (size_t)layer * D * D, T, D, D}; pg8::StaticOrder S; S.init(T, D, G, bid);
            pg8::EpiResid<true> E; E.base = xb_in; E.out = (layer == 3) ? OUT : nullptr; E.xb = xb_out; E.ss_out = SS + (size_t)((layer + 1) * 4) * T; E.alpha = 1.0f; E.ss_in = SS + (size_t)(layer * 4 + 3) * T; E.pp = PPb;

#ifndef DIS_PLE
 pg8::gemm_phase<pg8::EpiResid<true>, pg8::StaticOrder, true, true>(lds, g, S, E);
#endif
 }
        if (p + 1 < ph_hi) {
#pragma unroll 1
            for (int rr = 0; rr < REP_SYNC; ++rr) xcd_barrier(bar); }
    }
}

extern "C" void kernel_launch(void* const* d_in, const int* in_sizes, int n_in, void* d_out, int out_size, void* d_ws, size_t ws_size, hipStream_t stream) {
    static int grid = 0;
    if (grid == 0) {
        if (n_in != 21 || in_sizes[0] != T * D || out_size != T * D || ws_size < WS_END) { fprintf(stderr, "kernel_launch: unexpected problem (n_in %d, in0 %d, out %d, ws %zu; need ws >= %zu)\n", n_in, n_in > 0 ? in_sizes[0] : -1, out_size, ws_size, (size_t)WS_END); grid = -1; return; }
        int dev = 0, cus = 0, per_cu = 0;
        if (hipGetDevice(&dev) != hipSuccess || hipDeviceGetAttribute(&cus, hipDeviceAttributeMultiprocessorCount, dev) != hipSuccess) { fprintf(stderr, "kernel_launch: device query failed\n"); grid = -1; return; }
        if (hipFuncSetAttribute((const void*)fwd, hipFuncAttributeMaxDynamicSharedMemorySize, LDS_BYTES) != hipSuccess) { fprintf(stderr, "kernel_launch: hipFuncSetAttribute failed\n"); grid = -1; return; }
        if (hipOccupancyMaxActiveBlocksPerMultiprocessor(&per_cu, (const void*)fwd, NTHR, LDS_BYTES) != hipSuccess || per_cu < 1) { fprintf(stderr, "kernel_launch: occupancy query gave %d\n", per_cu); per_cu = 1; }
        (void)hipGetLastError();
        grid = cus;
    }
    if (grid < 0) return;
    (void)hipMemsetAsync((char*)d_ws + WS_BAR, 0, 16384, stream);
    Args a{};
    for (int i = 0; i < 21; ++i) a.in[i] = (const float*)d_in[i];
    a.out = (float*)d_out; a.ws = (unsigned char*)d_ws;
#if MK_PER_PHASE_LAUNCH
    for (int p = 0; p < NPHASE; ++p) { a.ph_lo = p; a.ph_hi = p + 1; hipLaunchKernelGGL(fwd, dim3(grid), dim3(NTHR), LDS_BYTES, stream, a); }
#else
    a.ph_lo = 0; a.ph_hi = NPHASE;
    void* args[] = {&a};
    const hipError_t e = hipLaunchCooperativeKernel((const void*)fwd, dim3(grid), dim3(NTHR), args, LDS_BYTES, stream);
    if (e != hipSuccess) fprintf(stderr, "kernel_launch: cooperative launch failed: %s (grid %d)\n", hipGetErrorString(e), grid);
#endif
}
```

```cpp
#include <hip/hip_runtime.h>
#include <hip/hip_cooperative_groups.h>
#include <cstdio>
#include <cstdint>
namespace cg = cooperative_groups;
namespace pg8 {
#define PG8_LAS __attribute__((address_space(3)))
typedef unsigned short bf16_t;
typedef short bf16x8 __attribute__((ext_vector_type(8)));
typedef float f32x4 __attribute__((ext_vector_type(4)));
typedef unsigned u32x4 __attribute__((ext_vector_type(4)));
constexpr int BM = 256, BK = 64, HALF = 128, HTB = HALF * BK * 2  , STAGE_BYTES = 8 * HTB, NXCD = 8, WGM = 4;

__host__ __device__ __forceinline__ int lds_byte(int r, int c) { const int st = (r >> 4) * 2 + (c >> 5), rr = r & 15, cc = c & 31, ob = rr * 64 + cc * 2; return st * 1024 + (ob ^ (((ob >> 9) & 1) << 5)); }
__host__ __device__ __forceinline__ void stage_rc(int b, int& R, int& C) { const int st = b / 1024, sb = b % 1024, swz = sb ^ (((sb >> 9) & 1) << 5); R = (st >> 1) * 16 + swz / 64; C = (st & 1) * 32 + (swz % 64) / 2; }
__host__ __device__ __forceinline__ int perm32(int rho) { const int n = rho >> 4, i = rho & 15; return 8 * (i >> 2) + 4 * n + (i & 3); }

struct Unit { int pm, pn; };
struct Gemm { const bf16_t* A; const bf16_t* Bt; int M, N, K; };

struct StaticOrder {
    int nM, nN, nwg, G, c;
    __host__ __device__ void init(int M, int N, int G_, int c_) { nM = M / BM; nN = N / BM; nwg = nM * nN; G = G_; c = c_; }
    __host__ __device__ bool next(int i, Unit& u) const {
        const long L = (long)i * G + c; if (L >= nwg) return false;
        int wgid = (int)L; { const int q = nwg / NXCD, r = nwg % NXCD, xcd = wgid % NXCD, off = wgid / NXCD; wgid = (xcd < r ? xcd * (q + 1) : r * (q + 1) + (xcd - r) * q) + off; }
        const int nig = WGM * nN, gid = wgid / nig, fm = gid * WGM, gsz = (nM - fm) < WGM ? (nM - fm) : WGM;
        u.pm = fm + ((wgid % nig) % gsz); u.pn = (wgid % nig) / gsz; return true;
    }
    __device__ __forceinline__ void a_ready(const Unit&) const {}
    __device__ __forceinline__ void done(const Unit&) const {}
};

__device__ __forceinline__ unsigned cvt_pk_bf16(float lo, float hi) { unsigned r; asm volatile("v_cvt_pk_bf16_f32 %0, %1, %2" : "=v"(r) : "v"(lo), "v"(hi)); return r; }
typedef float f32x2 __attribute__((ext_vector_type(2)));
template <class Epi, class Sched, bool ALIGN_EPI = false, bool SP2 = false>
__device__ __forceinline__ void gemm_phase(PG8_LAS unsigned char* lds, const Gemm g, const Sched& S, const Epi& E) {
    int tid_l = threadIdx.x; asm volatile("" : "+v"(tid_l));
    const int tid = tid_l, wid = __builtin_amdgcn_readfirstlane(tid >> 6), lane = tid & 63, wr = wid >> 2, wc = wid & 3, fr = lane & 15, fq = lane >> 4;
    const int K = g.K, nt = K / BK;
    unsigned voffA[2], voffB[2];
#pragma unroll
    for (int i = 0; i < 2; ++i) { int R, C; stage_rc(tid * 16 + i * 8192, R, C); const int Rb = Epi::PERM ? ((R & ~31) + perm32(R & 31)) : R;
        voffA[i] = (unsigned)(R * K + C) * 2u; voffB[i] = (unsigned)(Rb * K + C) * 2u; }
    const size_t kstep = (size_t)(BK * 2);
    const size_t hstep = (size_t)HALF * K * 2;
    const size_t tstep = 2 * hstep;
    const unsigned ldsw = (unsigned)wid * 1024u;
    const int aoff = lds_byte(wr * 64 + fr, fq * 8), boff = lds_byte(wc * 32 + fr, fq * 8);
#define PG8_SA(b, h) (((b) * 2 + (h)) * HTB)
#define PG8_SB(b, h) ((4 + (b) * 2 + (h)) * HTB)
#define PG8_STAGE(bufoff, gbase, voff) do { _Pragma("unroll") for (int _i = 0; _i < 2; ++_i) \
        __builtin_amdgcn_global_load_lds((const unsigned*)((const char*)(gbase) + (voff)[_i]), (PG8_LAS unsigned*)(lds + (bufoff) + ldsw + _i * 8192), 16, 0, 0); } while (0)
#define PG8_LDA(dst, b, h) do { _Pragma("unroll") for (int m = 0; m < 4; ++m) _Pragma("unroll") for (int k = 0; k < 2; ++k) dst[m][k] = *(const PG8_LAS bf16x8*)(lds + PG8_SA(b, h) + aoff + m * 2048 + k * 1024); } while (0)
#define PG8_LDB(dst, b, h) do { _Pragma("unroll") for (int n = 0; n < 2; ++n) _Pragma("unroll") for (int k = 0; k < 2; ++k) dst[n][k] = *(const PG8_LAS bf16x8*)(lds + PG8_SB(b, h) + boff + n * 2048 + k * 1024); } while (0)
#define PG8_MMA(ai, bj, At, Bt) do { __builtin_amdgcn_s_setprio(1); _Pragma("unroll") for (int m = 0; m < 4; ++m) _Pragma("unroll") for (int n = 0; n < 2; ++n) _Pragma("unroll") for (int k = 0; k < 2; ++k) \
        acc[ai][bj][m][n] = __builtin_amdgcn_mfma_f32_16x16x32_bf16(Bt[n][k], At[m][k], acc[ai][bj][m][n], 0, 0, 0); __builtin_amdgcn_s_setprio(0); } while (0)
#define PG8_WAIT_V(n) asm volatile("s_waitcnt vmcnt(" #n ")" ::: "memory")
#define PG8_WAIT_L(n) asm volatile("s_waitcnt lgkmcnt(" #n ")" ::: "memory")
#define PG8_BAR __builtin_amdgcn_s_barrier()
#define PG8_SCHED __builtin_amdgcn_sched_barrier(0)
    Unit cur, nxt; int ui = 0; float epre[8];
    if (!S.next(0, cur)) return;
    f32x4 acc[2][2][4][2];
#pragma unroll
    for (int a = 0; a < 2; ++a)
#pragma unroll
        for (int b = 0; b < 2; ++b)
#pragma unroll
            for (int m = 0; m < 4; ++m)
#pragma unroll
                for (int n = 0; n < 2; ++n) acc[a][b][m][n] = (f32x4){0.f, 0.f, 0.f, 0.f};
    bf16x8 At[4][2], B0[2][2], B1[2][2];
    const char* cA = (const char*)g.A + (size_t)cur.pm * tstep; const char* cB = (const char*)g.Bt + (size_t)cur.pn * tstep;
    S.a_ready(cur);
    if constexpr (SP2) {
        PG8_STAGE(PG8_SB(0, 0), cB, voffB); PG8_STAGE(PG8_SB(0, 1), cB + hstep, voffB); PG8_STAGE(PG8_SA(0, 0), cA, voffA); PG8_STAGE(PG8_SA(0, 1), cA + hstep, voffA);
        if (wr == 1) PG8_BAR;
        PG8_WAIT_V(2); PG8_BAR;
        PG8_STAGE(PG8_SB(1, 0), cB + kstep, voffB); PG8_STAGE(PG8_SA(1, 0), cA + kstep, voffA); PG8_STAGE(PG8_SB(1, 1), cB + hstep + kstep, voffB);
        PG8_WAIT_V(6); PG8_BAR;
    } else {
        PG8_STAGE(PG8_SB(0, 0), cB, voffB); PG8_STAGE(PG8_SA(0, 0), cA, voffA); PG8_STAGE(PG8_SB(0, 1), cB + hstep, voffB); PG8_STAGE(PG8_SA(0, 1), cA + hstep, voffA);
        if (wr == 1) PG8_BAR;
        PG8_WAIT_V(4); PG8_BAR;
        PG8_STAGE(PG8_SB(1, 0), cB + kstep, voffB); PG8_STAGE(PG8_SA(1, 0), cA + kstep, voffA); PG8_STAGE(PG8_SB(1, 1), cB + hstep + kstep, voffB);
        PG8_WAIT_V(6); PG8_BAR;
    }
    for (;;) {
        const bool has_next = S.next(ui + 1, nxt);
        const char* nA = has_next ? (const char*)g.A + (size_t)nxt.pm * tstep : cA; const char* nB = has_next ? (const char*)g.Bt + (size_t)nxt.pn * tstep : cB;
        for (int t = 0; t < nt; t += 2) {
            const bool last = (t == nt - 2);
            const char* a1 = cA + (size_t)(t + 1) * kstep;
            const char* a2 = last ? nA : cA + (size_t)(t + 2) * kstep; const char* b2 = last ? nB : cB + (size_t)(t + 2) * kstep;
            const char* a3 = a2 + kstep; const char* b3 = b2 + kstep;
            if (last && has_next) S.a_ready(nxt);
            if (last) E.prefetch(cur, wr, fr, epre);
            if constexpr (SP2) {
            PG8_LDB(B0, 0, 0); PG8_LDB(B1, 0, 1); PG8_SCHED; PG8_LDA(At, 0, 0); PG8_STAGE(PG8_SA(1, 1), a1 + hstep, voffA);
            PG8_WAIT_V(8); PG8_WAIT_L(0); PG8_BAR; PG8_MMA(0, 0, At, B0); PG8_MMA(0, 1, At, B1); PG8_BAR; PG8_SCHED;
            PG8_LDA(At, 0, 1); PG8_STAGE(PG8_SB(0, 0), b2, voffB); PG8_STAGE(PG8_SB(0, 1), b2 + hstep, voffB); PG8_STAGE(PG8_SA(0, 0), a2, voffA);
            PG8_WAIT_V(8); PG8_WAIT_L(0); PG8_BAR; PG8_MMA(1, 0, At, B0); PG8_MMA(1, 1, At, B1); PG8_BAR; PG8_SCHED;
            PG8_LDB(B0, 1, 0); PG8_LDB(B1, 1, 1); PG8_SCHED; PG8_LDA(At, 1, 0); PG8_STAGE(PG8_SA(0, 1), a2 + hstep, voffA);
            PG8_WAIT_V(8); PG8_WAIT_L(0); PG8_BAR; PG8_MMA(0, 0, At, B0); PG8_MMA(0, 1, At, B1); PG8_BAR; PG8_SCHED;
            PG8_LDA(At, 1, 1); PG8_STAGE(PG8_SB(1, 0), b3, voffB); PG8_STAGE(PG8_SB(1, 1), b3 + hstep, voffB); PG8_STAGE(PG8_SA(1, 0), a3, voffA);
            PG8_WAIT_V(8); PG8_WAIT_L(0); PG8_BAR; PG8_MMA(1, 0, At, B0); PG8_MMA(1, 1, At, B1); PG8_BAR; PG8_SCHED;
            } else {
            PG8_LDB(B0, 0, 0); PG8_SCHED; PG8_LDA(At, 0, 0); PG8_STAGE(PG8_SA(1, 1), a1 + hstep, voffA);
            PG8_WAIT_L(8); PG8_BAR; PG8_WAIT_L(0); PG8_MMA(0, 0, At, B0); PG8_BAR; PG8_SCHED;
            PG8_LDB(B1, 0, 1); PG8_STAGE(PG8_SB(0, 0), b2, voffB);
            PG8_BAR; PG8_WAIT_L(0); PG8_MMA(0, 1, At, B1); PG8_BAR;
            PG8_LDA(At, 0, 1); PG8_STAGE(PG8_SA(0, 0), a2, voffA);
            PG8_BAR; PG8_WAIT_L(0); PG8_MMA(1, 0, At, B0); PG8_BAR; PG8_SCHED;
            PG8_STAGE(PG8_SB(0, 1), b2 + hstep, voffB);
            PG8_WAIT_V(6); PG8_BAR; PG8_MMA(1, 1, At, B1); PG8_BAR;
            PG8_LDB(B0, 1, 0); PG8_SCHED; PG8_LDA(At, 1, 0); PG8_STAGE(PG8_SA(0, 1), a2 + hstep, voffA);
            PG8_WAIT_L(8); PG8_BAR; PG8_WAIT_L(0); PG8_MMA(0, 0, At, B0); PG8_BAR; PG8_SCHED;
            PG8_LDB(B1, 1, 1); PG8_STAGE(PG8_SB(1, 0), b3, voffB);
            PG8_BAR; PG8_WAIT_L(0); PG8_MMA(0, 1, At, B1); PG8_BAR;
            PG8_LDA(At, 1, 1); PG8_STAGE(PG8_SA(1, 0), a3, voffA);
            PG8_BAR; PG8_WAIT_L(0); PG8_MMA(1, 0, At, B0); PG8_BAR; PG8_SCHED;
            PG8_STAGE(PG8_SB(1, 1), b3 + hstep, voffB);
            PG8_WAIT_V(6); PG8_BAR; PG8_MMA(1, 1, At, B1); PG8_BAR;
            }
        }
        if constexpr (ALIGN_EPI) { if (wr == 0) PG8_BAR; }
        if constexpr (!Epi::AFTER_DRAIN) { E(acc, cur, wr, wc, fr, fq, epre); S.done(cur); }
        if (!has_next) break;
#pragma unroll
        for (int a = 0; a < 2; ++a)
#pragma unroll
            for (int b = 0; b < 2; ++b)
#pragma unroll
                for (int m = 0; m < 4; ++m)
#pragma unroll
                    for (int n = 0; n < 2; ++n) acc[a][b][m][n] = (f32x4){0.f, 0.f, 0.f, 0.f};
        cur = nxt; cA = nA; cB = nB; ++ui;
        if constexpr (ALIGN_EPI) { if (wr == 1) PG8_BAR; }
    }
    PG8_WAIT_V(0);
    if constexpr (!ALIGN_EPI) { if (wr == 0) PG8_BAR; }
    PG8_BAR;
    if constexpr (Epi::AFTER_DRAIN) { E.fused(acc, cur, wr, wc, fr, fq, lds, wid, lane); S.done(cur); }
#undef PG8_SA
#undef PG8_SB
#undef PG8_STAGE
#undef PG8_LDA
#undef PG8_LDB
#undef PG8_MMA
#undef PG8_WAIT_V
#undef PG8_WAIT_L
#undef PG8_BAR
#undef PG8_SCHED
}
}

#define LAS __attribute__((address_space(3)))
typedef unsigned short bf16;
typedef short bf16x8 __attribute__((ext_vector_type(8)));
typedef short bf16x4 __attribute__((ext_vector_type(4)));
typedef float f32x4 __attribute__((ext_vector_type(4)));
typedef float f32x16 __attribute__((ext_vector_type(16)));
typedef unsigned u32x4 __attribute__((ext_vector_type(4)));
typedef unsigned u32x2 __attribute__((ext_vector_type(2)));

constexpr int T = 16384, D = 1024, FF = 2816, PLE_DIM = 256;
constexpr float EPS = 1e-6f;
constexpr int NTHR = 512;
constexpr int LDS_BYTES = 155648;
constexpr int NPHASE = 39;
constexpr int LDS_BARST = LDS_BYTES - 64;
constexpr size_t MiB = (size_t)1 << 20;
constexpr size_t WS_SS = 598 * MiB, SS_ZERO_BYTES = 4 * MiB;
typedef long long ss_t;
constexpr size_t WS_BAR = WS_SS + 3 * MiB;
constexpr float SS_SCALE = 1048576.0f, SS_INV = 1.0f / (1024.0f * 1048576.0f);
constexpr size_t WS_WGU = 2 * MiB, WS_WDN = 90 * MiB, WS_WPG = 134 * MiB, WS_WPP = 142 * MiB, WS_HGIN = 144 * MiB, WS_HGOUT = 160 * MiB;
constexpr size_t WS_MLIN = 164 * MiB, WS_MLOUT = 170 * MiB, WS_SWIN = 172 * MiB, WS_SWOUT = 175 * MiB, WS_WIF = 177 * MiB;
constexpr size_t WS_PB = 178 * MiB, WS_PP = 210 * MiB, WS_XB0 = 242 * MiB, WS_XB1 = 274 * MiB;
constexpr size_t WS_ACT = 306 * MiB, WS_PROJ = 306 * MiB, WS_MIXO = 434 * MiB, WS_STATE = 466 * MiB;
constexpr size_t WS_DEC = 594 * MiB, WS_NST = 595 * MiB, WS_GATES = 596 * MiB, WS_LB = 597 * MiB, WS_PAR = 597 * MiB + 65536, WS_END = 602 * MiB;

__device__ __forceinline__ float bf2f(unsigned v) { return __uint_as_float(v << 16); }
__device__ __forceinline__ float bflo(unsigned w) { return __uint_as_float(w << 16); }
__device__ __forceinline__ float bfhi(unsigned w) { return __uint_as_float(w & 0xffff0000u); }
__device__ __forceinline__ unsigned pk2(float lo, float hi) { return pg8::cvt_pk_bf16(lo, hi); }
__device__ __forceinline__ float sigmoidf_(float x) { return __builtin_amdgcn_rcpf(1.0f + __expf(-x)); }
__device__ __forceinline__ float siluf_(float x) { return x * sigmoidf_(x); }
__device__ __forceinline__ int crow(int reg, int hh) { return (reg & 3) + 8 * (reg >> 2) + 4 * hh; }

#define XB_TMO      128
#define XB_XCNT(j)  (256  + 64 * (j))
#define XB_XSUB(j)  (1280 + 64 * (j))
#define XB_XGEN(j)  (2304 + 64 * (j))
#define XB_TOP      3328
#define XB_TOPGEN   3392
#define XCD_BAR_WORDS 3456
#define XB_SPIN_CAP (1u << 18)

__device__ __forceinline__ unsigned xb_ld(unsigned* p)              { return __hip_atomic_load(p, __ATOMIC_RELAXED, __HIP_MEMORY_SCOPE_AGENT); }
__device__ __forceinline__ unsigned xb_add(unsigned* p, unsigned v) { return __hip_atomic_fetch_add(p, v, __ATOMIC_RELAXED, __HIP_MEMORY_SCOPE_AGENT); }
__device__ __forceinline__ unsigned xb_xcc_id() { return (unsigned)__builtin_amdgcn_s_getreg((3 << 11) | 20) & 0xFu; }
#define XB_SPIN(cond, bar) do { unsigned _sp = 0; while (cond) { __builtin_amdgcn_s_sleep(1); \
    if ((++_sp & 255u) == 0u) { if (xb_ld(&(bar)[XB_TMO])) break; if (_sp > XB_SPIN_CAP) { atomicAdd(&(bar)[XB_TMO], 1u); break; } } } } while (0)

struct XcdBarrier {
    unsigned* bar; unsigned x;
    volatile LAS unsigned* st;
};

__device__ __forceinline__ XcdBarrier xcd_barrier_post(unsigned* bar, volatile LAS unsigned* st) {
    XcdBarrier b; b.bar = bar; b.x = xb_xcc_id(); b.st = st;
    if (threadIdx.x == 0) (void)xb_add(&bar[XB_XCNT(b.x)], 1u);
    return b;
}
__device__ __forceinline__ void xcd_barrier_complete(unsigned* bar, unsigned x, unsigned& nloc, unsigned& nx) {
    const unsigned G = gridDim.x * gridDim.y * gridDim.z;
    unsigned sum, cnt, mine, sp = 0u;
    for (;;) {
        sum = 0u; cnt = 0u; mine = 0u;
#pragma unroll
        for (unsigned j = 0; j < 16; ++j) { const unsigned c = xb_ld(&bar[XB_XCNT(j)]); sum += c; cnt += (c > 0u) ? 1u : 0u; mine = (j == x) ? c : mine; }
        if (sum == G) break;
        __builtin_amdgcn_s_sleep(1);
        if ((++sp & 255u) == 0u) { if (xb_ld(&bar[XB_TMO])) break; if (sp > XB_SPIN_CAP) { atomicAdd(&bar[XB_TMO], 1u); break; } }
    }
    nloc = mine > 0u ? mine : 1u; nx = cnt > 0u ? cnt : 1u;
}

__device__ __forceinline__ void xcd_barrier(const XcdBarrier& b) {
    asm volatile("s_waitcnt vmcnt(0)" ::: "memory");
    __syncthreads();
    if (threadIdx.x == 0) {
        unsigned* bar = b.bar;
        __builtin_amdgcn_s_waitcnt(0);
        unsigned nloc = b.st[0], nx = b.st[1];
        if (nloc == 0u) { xcd_barrier_complete(bar, b.x, nloc, nx); b.st[0] = nloc; b.st[1] = nx; }
        const unsigned old = xb_add(&bar[XB_XSUB(b.x)], 1u);
        const unsigned gen = old / nloc;
        if (old + 1u == (gen + 1u) * nloc) {
            __builtin_amdgcn_fence(__ATOMIC_RELEASE, "agent");
            asm volatile("s_waitcnt vmcnt(0)" ::: "memory");
            const unsigned og = xb_add(&bar[XB_TOP], 1u);
            const unsigned tg = og / nx;
            if (og + 1u == (tg + 1u) * nx) xb_add(&bar[XB_TOPGEN], 1u);
            else XB_SPIN(xb_ld(&bar[XB_TOPGEN]) == tg, bar);
            __builtin_amdgcn_fence(__ATOMIC_ACQUIRE, "agent");
            xb_add(&bar[XB_XGEN(b.x)], 1u);
            asm volatile("s_waitcnt vmcnt(0)" ::: "memory");
        } else {
            XB_SPIN(xb_ld(&bar[XB_XGEN(b.x)]) == gen, bar);
            __builtin_amdgcn_fence(__ATOMIC_ACQUIRE, "agent");
            asm volatile("s_waitcnt vmcnt(0)" ::: "memory");
        }
    }
    __syncthreads();
}

__device__ __forceinline__ void xcd_barrier_local(const XcdBarrier& b) {
    asm volatile("s_waitcnt vmcnt(0)" ::: "memory");
    __syncthreads();
    if (threadIdx.x == 0) {
        unsigned* bar = b.bar;
        __builtin_amdgcn_s_waitcnt(0);
        unsigned nloc = b.st[0]; if (nloc == 0u) nloc = 1u;
        const unsigned old = xb_add(&bar[XB_XSUB(b.x)], 1u);
        const unsigned gen = old / nloc;
        if (old + 1u == (gen + 1u) * nloc) xb_add(&bar[XB_XGEN(b.x)], 1u);
        else XB_SPIN(xb_ld(&bar[XB_XGEN(b.x)]) == gen, bar);
        __builtin_amdgcn_fence(__ATOMIC_ACQUIRE, "agent");
        asm volatile("s_waitcnt vmcnt(0)" ::: "memory");
    }
    __syncthreads();
}
#define XB_MAP 3584

namespace pg8 {
__device__ __forceinline__ float row_rs(const ss_t* ss, int row) { return ss ? __builtin_amdgcn_rsqf((float)ss[row] * SS_INV + 1e-6f) : 1.0f; }

struct EpiRsBf16 {
    static constexpr bool PERM = true, AFTER_DRAIN = false;
    bf16_t* O; int ldc; const ss_t* ss;
    __device__ __forceinline__ void prefetch(const Unit&, int, int, float (&)[8]) const {}
    __device__ __forceinline__ void operator()(const f32x4 (&acc)[2][2][4][2], const Unit& u, int wr, int wc, int fr, int fq, const float (&pre)[8]) const {
        const int row0 = u.pm * BM + wr * 64 + fr, col0 = u.pn * BM + wc * 32 + 8 * fq;
#pragma unroll
        for (int ai = 0; ai < 2; ++ai)
#pragma unroll
            for (int m = 0; m < 4; ++m) { const int row = row0 + ai * HALF + m * 16; const float sc = row_rs(ss, row); bf16_t* rowp = O + (size_t)row * ldc + col0;
#pragma unroll
                for (int bj = 0; bj < 2; ++bj) { const f32x4 v0 = acc[ai][bj][m][0] * sc, v1 = acc[ai][bj][m][1] * sc;
                    u32x4 w; w.x = cvt_pk_bf16(v0[0], v0[1]); w.y = cvt_pk_bf16(v0[2], v0[3]); w.z = cvt_pk_bf16(v1[0], v1[1]); w.w = cvt_pk_bf16(v1[2], v1[3]);
                    *(u32x4*)(rowp + bj * HALF) = w; } }
    }
};
struct EpiSwiGLU {
    static constexpr bool PERM = true, AFTER_DRAIN = false;
    bf16_t* O; int ldc; const ss_t* ss;
    __device__ __forceinline__ void prefetch(const Unit& u, int wr, int fr, float (&pre)[8]) const {
        const int row0 = u.pm * BM + wr * 64 + fr;
#pragma unroll
        for (int ai = 0; ai < 2; ++ai)
#pragma unroll
            for (int m = 0; m < 4; ++m) pre[ai * 4 + m] = row_rs(ss, row0 + ai * HALF + m * 16);
    }
    __device__ __forceinline__ void operator()(const f32x4 (&acc)[2][2][4][2], const Unit& u, int wr, int wc, int fr, int fq, const float (&pre)[8]) const {
        const int row0 = u.pm * BM + wr * 64 + fr, col0 = u.pn * HALF + wc * 32 + 8 * fq;
#pragma unroll
        for (int ai = 0; ai < 2; ++ai)
#pragma unroll
            for (int m = 0; m < 4; ++m) { const int row = row0 + ai * HALF + m * 16; const float sc = pre[ai * 4 + m];
                float r[8];
#pragma unroll
                for (int n = 0; n < 2; ++n)
#pragma unroll
                    for (int i = 0; i < 4; ++i) { const float g = acc[ai][0][m][n][i] * sc, uu = acc[ai][1][m][n][i] * sc;
                        r[n * 4 + i] = g * __builtin_amdgcn_rcpf(1.0f + __builtin_amdgcn_exp2f(-1.4426950408889634f * g)) * uu; }
                u32x4 w; w.x = cvt_pk_bf16(r[0], r[1]); w.y = cvt_pk_bf16(r[2], r[3]); w.z = cvt_pk_bf16(r[4], r[5]); w.w = cvt_pk_bf16(r[6], r[7]);
                *(u32x4*)(O + (size_t)row * ldc + col0) = w; }
    }
};
template <bool PLE_MODE> struct EpiResid {
    static constexpr bool PERM = true, AFTER_DRAIN = false;
    const bf16_t* base; bf16_t* xb; float* out; ss_t* ss_out; float alpha; const ss_t* ss_in; const bf16_t* pp;
    __device__ __forceinline__ void prefetch(const Unit&, int, int, float (&)[8]) const {}
    __device__ __forceinline__ void operator()(const f32x4 (&acc)[2][2][4][2], const Unit& u, int wr, int wc, int fr, int fq, const float (&pre)[8]) const {
        const int row0 = u.pm * BM + wr * 64 + fr, col0 = u.pn * BM + wc * 32 + 8 * fq;
#pragma unroll
        for (int ai = 0; ai < 2; ++ai)
#pragma unroll
            for (int m = 0; m < 4; ++m) { const int row = row0 + ai * HALF + m * 16; const size_t off = (size_t)row * 1024 + col0;
                const float sc = PLE_MODE ? row_rs(ss_in, row) : 0.f; float s = 0.f;
#pragma unroll
                for (int bj = 0; bj < 2; ++bj) { const size_t c = off + bj * HALF; const u32x4 bw = *(const u32x4*)(base + c);
                    const float b[8] = {__uint_as_float(bw.x << 16), __uint_as_float(bw.x & 0xffff0000u), __uint_as_float(bw.y << 16), __uint_as_float(bw.y & 0xffff0000u),
                                        __uint_as_float(bw.z << 16), __uint_as_float(bw.z & 0xffff0000u), __uint_as_float(bw.w << 16), __uint_as_float(bw.w & 0xffff0000u)};
                    float a[8] = {acc[ai][bj][m][0][0], acc[ai][bj][m][0][1], acc[ai][bj][m][0][2], acc[ai][bj][m][0][3], acc[ai][bj][m][1][0], acc[ai][bj][m][1][1], acc[ai][bj][m][1][2], acc[ai][bj][m][1][3]};
                    float v[8];
                    if (PLE_MODE) { const u32x4 pw = *(const u32x4*)(pp + c);
                        const float p[8] = {__uint_as_float(pw.x << 16), __uint_as_float(pw.x & 0xffff0000u), __uint_as_float(pw.y << 16), __uint_as_float(pw.y & 0xffff0000u),
                                            __uint_as_float(pw.z << 16), __uint_as_float(pw.z & 0xffff0000u), __uint_as_float(pw.w << 16), __uint_as_float(pw.w & 0xffff0000u)};
#pragma unroll
                        for (int i = 0; i < 8; ++i) v[i] = b[i] + __builtin_amdgcn_rcpf(1.0f + __expf(-a[i] * sc)) * p[i]; }
                    else {
#pragma unroll
                        for (int i = 0; i < 8; ++i) v[i] = b[i] + a[i] * alpha; }
                    u32x4 w; w.x = cvt_pk_bf16(v[0], v[1]); w.y = cvt_pk_bf16(v[2], v[3]); w.z = cvt_pk_bf16(v[4], v[5]); w.w = cvt_pk_bf16(v[6], v[7]);
                    *(u32x4*)(xb + c) = w;
                    if (out) { *(f32x4*)(out + c) = (f32x4){v[0], v[1], v[2], v[3]}; *(f32x4*)(out + c + 4) = (f32x4){v[4], v[5], v[6], v[7]}; }
#pragma unroll
                    for (int i = 0; i < 8; ++i) s += v[i] * v[i]; }
                s += __shfl_xor(s, 16); s += __shfl_xor(s, 32);
                if (fq == 0) __hip_atomic_fetch_add((unsigned long long*)(ss_out + row), (unsigned long long)(long long)(s * SS_SCALE), __ATOMIC_RELAXED, __HIP_MEMORY_SCOPE_AGENT); }
    }
};
}

template <int KS> __device__ __forceinline__ void mm32(f32x16& acc, const LAS bf16* a, int lda, const LAS bf16* b, int ldb, int lane) {
    const int r = lane & 31, hh = lane >> 5;
    const LAS bf16* ap = a + r * lda + 8 * hh; const LAS bf16* bp = b + r * ldb + 8 * hh;
#pragma unroll
    for (int ks = 0; ks < KS; ++ks) { const bf16x8 af = *(const LAS bf16x8*)(ap + 16 * ks); const bf16x8 bfr = *(const LAS bf16x8*)(bp + 16 * ks);
        acc = __builtin_amdgcn_mfma_f32_32x32x16_bf16(af, bfr, acc, 0, 0, 0); }
}
__device__ __forceinline__ void mm_accop(f32x16& acc, const LAS bf16* vrow, const f32x16& P, int ss, int hh) {
    bf16x8 pf; u32x4 pw;
    pw.x = pk2(P[8 * ss + 0], P[8 * ss + 1]); pw.y = pk2(P[8 * ss + 2], P[8 * ss + 3]); pw.z = pk2(P[8 * ss + 4], P[8 * ss + 5]); pw.w = pk2(P[8 * ss + 6], P[8 * ss + 7]);
    pf = __builtin_bit_cast(bf16x8, pw);
    const bf16x4 v0 = *(const LAS bf16x4*)(vrow + 16 * ss + 4 * hh), v1 = *(const LAS bf16x4*)(vrow + 16 * ss + 8 + 4 * hh);
    bf16x8 vf; vf[0] = v0[0]; vf[1] = v0[1]; vf[2] = v0[2]; vf[3] = v0[3]; vf[4] = v1[0]; vf[5] = v1[1]; vf[6] = v1[2]; vf[7] = v1[3];
    acc = __builtin_amdgcn_mfma_f32_32x32x16_bf16(vf, pf, acc, 0, 0, 0);
}
#define ZERO16(x) do { _Pragma("unroll") for (int _z = 0; _z < 16; ++_z) (x)[_z] = 0.f; } while (0)

struct Args { const float* in[21]; float* out; unsigned char* ws; int ph_lo, ph_hi; };

__device__ __forceinline__ void conv_item(const float* W, int ldw, int K, int N, const float* gain, bf16* WT, int swiglu, int item, LAS float* scr, int lane) {
    const int nblk = N / 32, kb = item / nblk, nb = item - kb * nblk, k0 = 64 * kb, n0 = 32 * nb;
    int drow0 = n0;
    if (swiglu) { drow0 = (n0 < FF) ? (256 * (n0 / 128) + (n0 % 128)) : (256 * ((n0 - FF) / 128) + 128 + ((n0 - FF) % 128)); }
    { float wv[32]; const float* wp = W + (size_t)(k0 + (lane >> 5)) * ldw + n0 + (lane & 31); const float gl = gain ? gain[k0 + lane] : 1.0f;
#pragma unroll
      for (int i = 0; i < 32; ++i) wv[i] = __builtin_nontemporal_load(wp + (size_t)(2 * i) * ldw);
#pragma unroll
      for (int i = 0; i < 32; ++i) { const float g = __shfl(gl, 2 * i + (lane >> 5)); scr[(2 * i + (lane >> 5)) * 33 + (lane & 31)] = wv[i] * g; } }
    asm volatile("s_waitcnt lgkmcnt(0)" ::: "memory");
    const int c = lane & 7;
#pragma unroll
    for (int j = 0; j < 4; ++j) { const int n = (lane >> 3) + 8 * j; const LAS float* s = scr + (8 * c) * 33 + n;
        u32x4 o; o.x = pk2(s[0 * 33], s[1 * 33]); o.y = pk2(s[2 * 33], s[3 * 33]); o.z = pk2(s[4 * 33], s[5 * 33]); o.w = pk2(s[6 * 33], s[7 * 33]);
        *(u32x4*)(WT + (size_t)(drow0 + n) * K + k0 + 8 * c) = o; }
    asm volatile("s_waitcnt lgkmcnt(0)" ::: "memory");
}

__device__ __forceinline__ void prologue(const Args& a, LAS unsigned char* lds, int tid, int G) {
    const int lane = tid & 63, w = tid >> 6;
    unsigned char* ws = a.ws;
    LAS float* scr = (LAS float*)(lds + w * 16384);
    const int gw = blockIdx.x * 8 + w, NGW = G * 8;
    const float* ng = a.in[2];
    constexpr int I_GU = 16 * 176, I_DN = 44 * 32, I_PG = 16 * 32, I_PP = 4 * 32, I_HGIN = 16 * 128, I_SQ = 16 * 32, I_MLIN = 16 * 96, I_SWIN = 16 * 48;
    constexpr int NITEMS = 8 * I_GU + 8 * I_DN + 4 * I_PG + 4 * I_PP + 2 * I_HGIN + 2 * I_SQ + I_MLIN + I_SQ + I_SWIN + I_SQ;
    for (int it = gw; it < NITEMS; it += NGW) {
        int r = it;
        if (r < 8 * I_GU) { const int b = r / I_GU; r -= b * I_GU; conv_item(a.in[3] + (size_t)b * D * 2 * FF, 2 * FF, D, 2 * FF, ng + ((b >> 1) * 4 + (b & 1) * 2) * D, (bf16*)(ws + WS_WGU) + (size_t)b * 2 * FF * D, 1, r, scr, lane); continue; } r -= 8 * I_GU;
        if (r < 8 * I_DN) { const int b = r / I_DN; r -= b * I_DN; conv_item(a.in[4] + (size_t)b * FF * D, D, FF, D, nullptr, (bf16*)(ws + WS_WDN) + (size_t)b * D * FF, 0, r, scr, lane); continue; } r -= 8 * I_DN;
        if (r < 4 * I_PG) { const int b = r / I_PG; r -= b * I_PG; conv_item(a.in[5] + (size_t)b * D * D, D, D, D, ng + (b * 4 + 3) * D, (bf16*)(ws + WS_WPG) + (size_t)b * D * D, 0, r, scr, lane); continue; } r -= 4 * I_PG;
        if (r < 4 * I_PP) { const int b = r / I_PP; r -= b * I_PP; conv_item(a.in[6] + (size_t)b * PLE_DIM * D, D, PLE_DIM, D, nullptr, (bf16*)(ws + WS_WPP) + (size_t)b * D * PLE_DIM, 0, r, scr, lane); continue; } r -= 4 * I_PP;
        if (r < 2 * I_HGIN) { const int b = r / I_HGIN; r -= b * I_HGIN; conv_item(a.in[8] + (size_t)b * D * 4 * D, 4 * D, D, 4 * D, ng + (b * 3 * 4 + 1) * D, (bf16*)(ws + WS_HGIN) + (size_t)b * 4 * D * D, 0, r, scr, lane); continue; } r -= 2 * I_HGIN;
        if (r < 2 * I_SQ) { const int b = r / I_SQ; r -= b * I_SQ; conv_item(a.in[10] + (size_t)b * D * D, D, D, D, nullptr, (bf16*)(ws + WS_HGOUT) + (size_t)b * D * D, 0, r, scr, lane); continue; } r -= 2 * I_SQ;
        if (r < I_MLIN) { conv_item(a.in[11], 3 * D, D, 3 * D, ng + (1 * 4 + 1) * D, (bf16*)(ws + WS_MLIN), 0, r, scr, lane); continue; } r -= I_MLIN;
        if (r < I_SQ) { conv_item(a.in[15], D, D, D, nullptr, (bf16*)(ws + WS_MLOUT), 0, r, scr, lane); continue; } r -= I_SQ;
        if (r < I_SWIN) { conv_item(a.in[16], 1536, D, 1536, ng + (2 * 4 + 1) * D, (bf16*)(ws + WS_SWIN), 0, r, scr, lane); continue; } r -= I_SWIN;
        conv_item(a.in[20], D, D, D, nullptr, (bf16*)(ws + WS_SWOUT), 0, r, scr, lane);
    }
    { u32x4* z = (u32x4*)(ws + WS_SS + (size_t)T * 8); const int nz = 16 * T * 8 / 16;
      for (int i = blockIdx.x * NTHR + tid; i < nz; i += G * NTHR) z[i] = (u32x4){0u, 0u, 0u, 0u}; }
    { const f32x4* p4 = (const f32x4*)a.in[1]; u32x4* o4 = (u32x4*)(ws + WS_PB); const int n8 = 4 * T * PLE_DIM / 8;
#pragma unroll 4
      for (int i = blockIdx.x * NTHR + tid; i < n8; i += G * NTHR) { const f32x4 v0 = __builtin_nontemporal_load(p4 + 2 * i), v1 = __builtin_nontemporal_load(p4 + 2 * i + 1);
          u32x4 o; o.x = pk2(v0[0], v0[1]); o.y = pk2(v0[2], v0[3]); o.z = pk2(v1[0], v1[1]); o.w = pk2(v1[2], v1[3]); o4[i] = o; } }
    { ss_t* ss0 = (ss_t*)(ws + WS_SS); bf16* xb = (bf16*)(ws + WS_XB0);
      for (int m = gw; m < T; m += NGW) { const f32x4* xr = (const f32x4*)(a.in[0] + (size_t)m * D) + lane; u32x2* o = (u32x2*)(xb + (size_t)m * D) + lane; float s = 0.f;
#pragma unroll
          for (int j = 0; j < 4; ++j) { const f32x4 v = __builtin_nontemporal_load(xr + 64 * j); s += (v[0] * v[0] + v[1] * v[1]) + (v[2] * v[2] + v[3] * v[3]); u32x2 q; q.x = pk2(v[0], v[1]); q.y = pk2(v[2], v[3]); o[64 * j] = q; }
#pragma unroll
          for (int o2 = 1; o2 < 64; o2 <<= 1) s += __shfl_xor(s, o2);
          if (lane == 0) ss0[m] = (ss_t)(s * SS_SCALE); } }
    { float* wif = (float*)(ws + WS_WIF); const float* g1 = ng + (1 * 4 + 1) * D;
      for (int i = blockIdx.x * NTHR + tid; i < D * 8; i += G * NTHR) wif[i] = a.in[12][i] * g1[i >> 3];
      float* lbo = (float*)(ws + WS_LB); const float* hl = a.in[7];
      for (int k = blockIdx.x * NTHR + tid; k < D; k += G * NTHR) { const float v0 = hl[k], v1 = hl[D + k], v2 = hl[2 * D + k], v3 = hl[3 * D + k];
          const float mx = fmaxf(fmaxf(v0, v1), fmaxf(v2, v3)); const float e0 = expf(v0 - mx), e1 = expf(v1 - mx), e2 = expf(v2 - mx), e3 = expf(v3 - mx);
          lbo[k] = 0.f; lbo[D + k] = (e1 + e2 + e3) / (e0 + e1 + e2 + e3); }
      float* par = (float*)(ws + WS_PAR);
      if (blockIdx.x == 0) { for (int i = tid; i < 256; i += NTHR) par[i] = a.in[9][i]; if (tid < 8) par[256 + tid] = a.in[13][tid];
          for (int i = tid; i < 1024; i += NTHR) par[512 + i] = a.in[14][i]; if (tid < 64) { par[1536 + tid] = a.in[17][tid]; par[1600 + tid] = a.in[18][tid]; } if (tid < 16) par[1664 + tid] = a.in[19][tid]; } }
}

__device__ __forceinline__ void hg_gate(float f, float lb, float& lf, float& kk) {
    f = fminf(fmaxf(f, -30.f), 30.f);
    const float e = __expf(-f), r = __builtin_amdgcn_rcpf(1.0f + e);
    const float fo = lb + (1.0f - lb) * r; lf = __logf(fo); kk = (1.0f - lb) * (e * r);
}
template <int CNT> __device__ __forceinline__ void stage_vt(const bf16* src  , LAS bf16* dst  , int ld, bool valid) {
#pragma unroll
    for (int q = 0; q < CNT / 8; ++q) { u32x4 v = valid ? *(const u32x4*)(src + 8 * q) : (u32x4){0u, 0u, 0u, 0u};
        LAS bf16* d = dst + (8 * q) * ld;
        d[0 * ld] = (bf16)(v.x & 0xffffu); d[1 * ld] = (bf16)(v.x >> 16); d[2 * ld] = (bf16)(v.y & 0xffffu); d[3 * ld] = (bf16)(v.y >> 16);
        d[4 * ld] = (bf16)(v.z & 0xffffu); d[5 * ld] = (bf16)(v.z >> 16); d[6 * ld] = (bf16)(v.w & 0xffffu); d[7 * ld] = (bf16)(v.w >> 16); }
}
#define LDS_BAR() do { asm volatile("s_waitcnt lgkmcnt(0)" ::: "memory"); __builtin_amdgcn_s_barrier(); asm volatile("" ::: "memory"); } while (0)
__device__ __forceinline__ void stage_vt8(u32x4 v, LAS bf16* d, int ld) {
    d[0 * ld] = (bf16)(v.x & 0xffffu); d[1 * ld] = (bf16)(v.x >> 16); d[2 * ld] = (bf16)(v.y & 0xffffu); d[3 * ld] = (bf16)(v.y >> 16);
    d[4 * ld] = (bf16)(v.z & 0xffffu); d[5 * ld] = (bf16)(v.z >> 16); d[6 * ld] = (bf16)(v.w & 0xffffu); d[7 * ld] = (bf16)(v.w >> 16);
}
__device__ __forceinline__ void hg_phaseA(LAS unsigned char* lds, const bf16* proj, const float* lbv, float* state, float* dec, int tid, int G) {
    LAS bf16* KUt = (LAS bf16*)lds;
    LAS bf16* Vt = (LAS bf16*)(lds + 18432);
    LAS float* totl = (LAS float*)(lds + 36864);
    const int lane = tid & 63, w = tid >> 6, k = tid & 127, qtr = tid >> 7, tl = lane & 31;
    const int vt = w >> 1, kt0 = (w & 1) * 2;
    for (int item = blockIdx.x; item < 256; item += G) {
        const int sc = item >> 3, hd = item & 7;
        const float lb = lbv[hd * 128 + k];
        f32x16 S0, S1; ZERO16(S0); ZERO16(S1); float btot = 0.f;
        unsigned fr[16]; u32x4 va, vb;
#define HGA_LOAD(T0) do { const bf16* fp_ = proj + (size_t)((T0) + 16 * qtr) * 4096 + 1024 + hd * 128 + k; _Pragma("unroll") for (int i = 0; i < 16; ++i) fr[i] = fp_[(size_t)i * 4096]; \
            const u32x4* vp_ = (const u32x4*)(proj + (size_t)((T0) + (tid & 63)) * 4096 + 2048 + hd * 128 + 16 * (tid >> 6)); va = vp_[0]; vb = vp_[1]; } while (0)
        HGA_LOAD(sc * 512);
#pragma unroll 1
        for (int jc = 0; jc < 8; ++jc) { const int t0 = (sc * 8 + jc) * 64;
            float c[16], kk[16];
            { float run = 0.f;
#pragma unroll
              for (int i = 0; i < 16; ++i) { float lf; hg_gate(bf2f(fr[i]), lb, lf, kk[i]); run += lf; c[i] = run; }
              totl[qtr * 128 + k] = run; }
            { LAS bf16* vd = Vt + (16 * (tid >> 6)) * 72 + (tid & 63); stage_vt8(va, vd, 72); stage_vt8(vb, vd + 8 * 72, 72); }
            if (jc < 7) HGA_LOAD(t0 + 64);
            LDS_BAR();
            float off = 0.f, tot = 0.f;
#pragma unroll
            for (int q = 0; q < 4; ++q) { const float v = totl[q * 128 + k]; if (q < qtr) off += v; tot += v; }
            btot += tot;
            { float o[16];
#pragma unroll
              for (int i = 0; i < 16; ++i) o[i] = kk[i] * __expf(tot - (off + c[i]));
              u32x4 w0, w1; w0.x = pk2(o[0], o[1]); w0.y = pk2(o[2], o[3]); w0.z = pk2(o[4], o[5]); w0.w = pk2(o[6], o[7]);
              w1.x = pk2(o[8], o[9]); w1.y = pk2(o[10], o[11]); w1.z = pk2(o[12], o[13]); w1.w = pk2(o[14], o[15]);
              LAS u32x4* d = (LAS u32x4*)(KUt + k * 72 + 16 * qtr); d[0] = w0; d[1] = w1; }
            LDS_BAR();
            { const int ka = 32 * kt0 + tl, kb = ka + 32;
              const float da = __expf((totl[ka] + totl[128 + ka]) + (totl[256 + ka] + totl[384 + ka])), db = __expf((totl[kb] + totl[128 + kb]) + (totl[256 + kb] + totl[384 + kb]));
#pragma unroll
              for (int r = 0; r < 16; ++r) { S0[r] *= da; S1[r] *= db; }
              mm32<4>(S0, Vt + (32 * vt) * 72, 72, KUt + (32 * kt0) * 72, 72, lane);
              mm32<4>(S1, Vt + (32 * vt) * 72, 72, KUt + (32 * kt0 + 32) * 72, 72, lane); }
            LDS_BAR();
        }
        { float* sp = state + (size_t)item * 16384;
#pragma unroll
          for (int r = 0; r < 16; ++r) { sp[(32 * vt + crow(r, lane >> 5)) * 128 + 32 * kt0 + tl] = S0[r]; sp[(32 * vt + crow(r, lane >> 5)) * 128 + 32 * kt0 + 32 + tl] = S1[r]; } }
        if (qtr == 0) dec[(size_t)sc * 1024 + hd * 128 + k] = __expf(btot);
    }
}
__device__ __forceinline__ void scan_phase(float* state, const float* dec, int ml, float* nst, int nsteps, int tid, int G) {
    for (int e = blockIdx.x * NTHR + tid; e < 131072; e += G * NTHR) {
        float* st = state + e; const float* dp; int dstride;
        if (ml) { dp = dec + (e >> 15); dstride = 4; } else { dp = dec + (e >> 14) * 128 + (e & 127); dstride = 1024; }
        float s = 0.f;
        for (int n0 = 0; n0 < nsteps; n0 += 16) { float u[16], d[16];
#pragma unroll
            for (int j = 0; j < 16; ++j) { u[j] = st[(size_t)(n0 + j) * 131072]; d[j] = dp[(n0 + j) * dstride]; }
#pragma unroll
            for (int j = 0; j < 16; ++j) { st[(size_t)(n0 + j) * 131072] = s; s = d[j] * s + u[j]; } }
    }
    if (ml) { const int e = blockIdx.x * NTHR + tid;
        if (e < 512) { float* st = nst + e; const float* dp = dec + (e >> 7); float s = 0.f;
            for (int n = 0; n < nsteps; ++n) { const float u = st[n * 512], d = dp[n * 4]; st[n * 512] = s; s = d * s + u; } } }
}
__device__ __forceinline__ void hg_phaseC(LAS unsigned char* lds, const bf16* proj, const float* lbv, const float* state, const float* gnorm, bf16* mixo, int tid, int G) {
    LAS bf16* QA = (LAS bf16*)lds;
    LAS bf16* KA = (LAS bf16*)(lds + 17408);
    LAS bf16* QB = (LAS bf16*)(lds + 34816);
    LAS bf16* Vt = (LAS bf16*)(lds + 52224);
    LAS bf16* Sb = (LAS bf16*)(lds + 70656);
    LAS float* totl = (LAS float*)(lds + 105472);
    LAS float* red = (LAS float*)(lds + 107520);
    LAS bf16* KUt = (LAS bf16*)(lds + 108544);
    const int lane = tid & 63, w = tid >> 6, k = tid & 127, qtr = tid >> 7, tl = lane & 31, hh = lane >> 5;
    const int svt = w >> 1, skt0 = (w & 1) * 2;
    for (int item = blockIdx.x; item < 256; item += G) {
        const int sc = item >> 3, hd = item & 7;
        const float lb = lbv[hd * 128 + k];
        f32x16 S0, S1;
        { const float* sp = state + (size_t)item * 16384;
#pragma unroll
          for (int r = 0; r < 16; ++r) { S0[r] = sp[(32 * svt + crow(r, hh)) * 128 + 32 * skt0 + tl]; S1[r] = sp[(32 * svt + crow(r, hh)) * 128 + 32 * skt0 + 32 + tl]; } }
        unsigned fr[16], qr[16]; u32x4 va, vb;
#define HGC_LOAD(T0) do { const bf16* fp_ = proj + (size_t)((T0) + 16 * qtr) * 4096 + hd * 128 + k; _Pragma("unroll") for (int i = 0; i < 16; ++i) { fr[i] = fp_[(size_t)i * 4096 + 1024]; qr[i] = fp_[(size_t)i * 4096]; } \
            const u32x4* vp_ = (const u32x4*)(proj + (size_t)((T0) + (tid & 63)) * 4096 + 2048 + hd * 128 + 16 * (tid >> 6)); va = vp_[0]; vb = vp_[1]; } while (0)
        HGC_LOAD(sc * 512);
#pragma unroll 1
        for (int jc = 0; jc < 8; ++jc) { const int t0 = (sc * 8 + jc) * 64;
            float c[16], kk[16], qv[16];
            { float run = 0.f;
#pragma unroll
              for (int i = 0; i < 16; ++i) { float lf; hg_gate(bf2f(fr[i]), lb, lf, kk[i]); run += lf; c[i] = run; qv[i] = siluf_(bf2f(qr[i])); }
              totl[qtr * 128 + k] = run; }
            { LAS bf16* vd = Vt + (16 * (tid >> 6)) * 72 + (tid & 63); stage_vt8(va, vd, 72); stage_vt8(vb, vd + 8 * 72, 72); }
            if (jc < 7) HGC_LOAD(t0 + 64);
#pragma unroll
            for (int r = 0; r < 16; r += 2) { const unsigned p0 = pk2(S0[r], S0[r + 1]), p1 = pk2(S1[r], S1[r + 1]);
                LAS bf16* d0 = Sb + (32 * svt + crow(r, hh)) * 136 + 32 * skt0 + tl;
                d0[0] = (bf16)(p0 & 0xffffu); d0[136] = (bf16)(p0 >> 16); d0[32] = (bf16)(p1 & 0xffffu); d0[136 + 32] = (bf16)(p1 >> 16); }
            LDS_BAR();
            { float off = 0.f, tot = 0.f;
#pragma unroll
              for (int q = 0; q < 4; ++q) { const float v = totl[q * 128 + k]; if (q < qtr) off += v; tot += v; }
              const float bmid = totl[k] + totl[128 + k];
              float o[16];
              const float ebm = __expf(bmid), etm = __expf(tot - bmid);
#pragma unroll
              for (int i = 0; i < 16; ++i) { const int t = 16 * qtr + i; const float b = off + c[i]; const float e1 = __expf(b - bmid), r1 = __builtin_amdgcn_rcpf(e1); const float qa = qv[i] * e1, ka = kk[i] * r1;
                  QA[t * 136 + k] = (bf16)(pk2(qa, 0.f) & 0xffffu);
                  KA[t * 136 + k] = (bf16)(pk2(ka, 0.f) & 0xffffu);
                  QB[t * 136 + k] = (bf16)(pk2(qa * ebm, 0.f) & 0xffffu);
                  o[i] = ka * etm; }
              u32x4 w0, w1; w0.x = pk2(o[0], o[1]); w0.y = pk2(o[2], o[3]); w0.z = pk2(o[4], o[5]); w0.w = pk2(o[6], o[7]);
              w1.x = pk2(o[8], o[9]); w1.y = pk2(o[10], o[11]); w1.z = pk2(o[12], o[13]); w1.w = pk2(o[14], o[15]);
              LAS u32x4* d = (LAS u32x4*)(KUt + k * 72 + 16 * qtr); d[0] = w0; d[1] = w1; }
            LDS_BAR();
            const int tb = w >> 2, vt = w & 3;
            u32x2 ogw[4];
            { const bf16* ogp = proj + (size_t)(t0 + 32 * tb + tl) * 4096 + 3072 + hd * 128 + 32 * vt + 4 * hh;
#pragma unroll
              for (int g = 0; g < 4; ++g) ogw[g] = *(const u32x2*)(ogp + 8 * g); }
            f32x16 acc; ZERO16(acc);
#pragma unroll
            for (int sb = 0; sb < 2; ++sb) { if (sb <= tb) { f32x16 P; ZERO16(P);
                mm32<8>(P, KA + (32 * sb) * 136, 136, QA + (32 * tb) * 136, 136, lane);
                if (sb == tb) {
#pragma unroll
                    for (int r = 0; r < 16; ++r) if (crow(r, hh) > tl) P[r] = 0.f; }
                const LAS bf16* vrow = Vt + (32 * vt + tl) * 72 + 32 * sb;
                mm_accop(acc, vrow, P, 0, hh); mm_accop(acc, vrow, P, 1, hh); } }
            mm32<8>(acc, Sb + (32 * vt) * 136, 136, QB + (32 * tb) * 136, 136, lane);
            float ssq = 0.f;
#pragma unroll
            for (int r = 0; r < 16; ++r) ssq += acc[r] * acc[r];
            ssq += __shfl_xor(ssq, 32);
            if (lane < 32) red[vt * 64 + 32 * tb + lane] = ssq;
            { const int ka = 32 * skt0 + tl, kb = ka + 32;
              const float da = __expf((totl[ka] + totl[128 + ka]) + (totl[256 + ka] + totl[384 + ka])), db = __expf((totl[kb] + totl[128 + kb]) + (totl[256 + kb] + totl[384 + kb]));
#pragma unroll
              for (int r = 0; r < 16; ++r) { S0[r] *= da; S1[r] *= db; }
              mm32<4>(S0, Vt + (32 * svt) * 72, 72, KUt + (32 * skt0) * 72, 72, lane);
              mm32<4>(S1, Vt + (32 * svt) * 72, 72, KUt + (32 * skt0 + 32) * 72, 72, lane); }
            LDS_BAR();
            { const int t = 32 * tb + tl; const float tot = (red[t] + red[64 + t]) + (red[128 + t] + red[192 + t]); const float rms = __builtin_amdgcn_rsqf(tot * (1.0f / 128.0f) + EPS);
              bf16* op = mixo + (size_t)(t0 + t) * 1024 + hd * 128;
#pragma unroll
              for (int g = 0; g < 4; ++g) { const int v0 = 32 * vt + 8 * g + 4 * hh; const u32x2 ow = ogw[g]; const f32x4 gn = *(const f32x4*)(gnorm + v0);
                  const float o0 = acc[4 * g + 0] * rms * gn[0] * siluf_(bflo(ow.x)), o1 = acc[4 * g + 1] * rms * gn[1] * siluf_(bfhi(ow.x));
                  const float o2 = acc[4 * g + 2] * rms * gn[2] * siluf_(bflo(ow.y)), o3 = acc[4 * g + 3] * rms * gn[3] * siluf_(bfhi(ow.y));
                  u32x2 o; o.x = pk2(o0, o1); o.y = pk2(o2, o3); *(u32x2*)(op + v0) = o; } }
            LDS_BAR();
        }
    }
}

constexpr float ML_SCALE = 0.08838834764831845f;
__device__ __forceinline__ void ml_gates(LAS unsigned char* lds, const bf16* xb, const ss_t* ss, const float* wif, const float* bif, float* gates, int tid, int G) {
    LAS float* wl = (LAS float*)lds;
    const int lane = tid & 63, w = tid >> 6;
    for (int i = tid; i < 8192; i += NTHR) wl[i] = wif[i];
    __syncthreads();
    const int rbase = (G == 256) ? (2048 * ((int)blockIdx.x & 7) + 64 * ((int)blockIdx.x >> 3) + 4 * w) : ((int)blockIdx.x * 8 + w) * 4;
    const int rstep = (G == 256) ? 32 : G * 32, rend = (G == 256) ? (rbase + 64) : T;
    for (int row0 = rbase; row0 < rend; row0 += rstep) { float a[4][8]; unsigned xr[4][16];
#pragma unroll
        for (int r = 0; r < 4; ++r) { const bf16* xp = xb + (size_t)(row0 + r) * 1024 + lane;
#pragma unroll
            for (int i = 0; i < 16; ++i) xr[r][i] = xp[64 * i]; }
#pragma unroll
        for (int r = 0; r < 4; ++r)
#pragma unroll
            for (int j = 0; j < 8; ++j) a[r][j] = 0.f;
#pragma unroll
        for (int i = 0; i < 16; ++i) { const int kx = lane + 64 * i; const f32x4 w0 = *(const LAS f32x4*)(wl + kx * 8), w1 = *(const LAS f32x4*)(wl + kx * 8 + 4);
#pragma unroll
            for (int r = 0; r < 4; ++r) { const float xv = bf2f(xr[r][i]);
                a[r][0] += xv * w0[0]; a[r][1] += xv * w0[1]; a[r][2] += xv * w0[2]; a[r][3] += xv * w0[3]; a[r][4] += xv * w1[0]; a[r][5] += xv * w1[1]; a[r][6] += xv * w1[2]; a[r][7] += xv * w1[3]; } }
#pragma unroll
        for (int r = 0; r < 4; ++r)
#pragma unroll
            for (int j = 0; j < 8; ++j) {
#pragma unroll
                for (int o = 1; o < 64; o <<= 1) a[r][j] += __shfl_xor(a[r][j], o); }
        if (lane < 4) { const int row = row0 + lane; const float rs = 1.0f / sqrtf((float)ss[row] * SS_INV + EPS); float o[8];
#pragma unroll
            for (int j = 0; j < 8; ++j) { float g = (lane == 0 ? a[0][j] : lane == 1 ? a[1][j] : lane == 2 ? a[2][j] : a[3][j]) * rs + bif[j]; g = 15.0f * tanhf(g * (1.0f / 15.0f)); o[j] = (j < 4) ? g : -log1pf(expf(-g)); }
            f32x4* gp = (f32x4*)(gates + (size_t)row * 8); gp[0] = (f32x4){o[0], o[1], o[2], o[3]}; gp[1] = (f32x4){o[4], o[5], o[6], o[7]}; }
    }
    __syncthreads();
}
__device__ __forceinline__ void ml_phaseA(LAS unsigned char* lds, const bf16* proj, const float* gates, float* state, float* dec, float* nst, int tid, int G) {
    LAS bf16* KUt = (LAS bf16*)lds;
    LAS bf16* Vt = (LAS bf16*)(lds + 18432);
    LAS float* wsrc = (LAS float*)(lds + 55296);
    LAS float* lfv = (LAS float*)(lds + 55552);
    LAS float* bcs = (LAS float*)(lds + 55808);
    const int lane = tid & 63, w = tid >> 6, k = tid & 127, qtr = tid >> 7, tl = lane & 31;
    for (int item = blockIdx.x; item < 256; item += G) {
        const int sc = item >> 2, hd = item & 3;
        f32x16 S0, S1, S2, S3; ZERO16(S0); ZERO16(S1); ZERO16(S2); ZERO16(S3); float nrun = 0.f, btot = 0.f;
        unsigned kr[16]; u32x4 vr[4]; float lfn = 0.f, ign = 0.f;
#define MLA_LOAD(T0) do { const bf16* kp_ = proj + (size_t)((T0) + 16 * qtr) * 3072 + 512 + hd * 128 + k; _Pragma("unroll") for (int i = 0; i < 16; ++i) kr[i] = kp_[(size_t)i * 3072]; \
            const u32x4* vp_ = (const u32x4*)(proj + (size_t)((T0) + (tid & 63)) * 3072 + 1024 + hd * 256 + 32 * (tid >> 6)); vr[0] = vp_[0]; vr[1] = vp_[1]; vr[2] = vp_[2]; vr[3] = vp_[3]; \
            if (tid < 64) { lfn = gates[(size_t)((T0) + tid) * 8 + 4 + hd]; ign = gates[(size_t)((T0) + tid) * 8 + hd]; } } while (0)
        MLA_LOAD(sc * 256);
#pragma unroll 1
        for (int jc = 0; jc < 4; ++jc) { const int t0 = (sc * 4 + jc) * 64;
            const float ig = ign;
            if (tid < 64) lfv[tid] = lfn;
            { LAS bf16* vd = Vt + (32 * (tid >> 6)) * 72 + (tid & 63); stage_vt8(vr[0], vd, 72); stage_vt8(vr[1], vd + 8 * 72, 72); stage_vt8(vr[2], vd + 16 * 72, 72); stage_vt8(vr[3], vd + 24 * 72, 72); }
            unsigned kc[16];
#pragma unroll
            for (int i = 0; i < 16; ++i) kc[i] = kr[i];
            if (jc < 3) MLA_LOAD(t0 + 64);
            LDS_BAR();
            if (tid < 64) { float b = 0.f, bc = 0.f;
                for (int s = 0; s < 64; ++s) { const float v = lfv[s]; bc += v; if (s <= tid) b += v; }
                wsrc[tid] = __expf(bc - b + ig) * ML_SCALE; if (tid == 0) bcs[0] = bc; }
            LDS_BAR();
            { float o[16];
#pragma unroll
              for (int i = 0; i < 16; ++i) o[i] = bf2f(kc[i]) * wsrc[16 * qtr + i];
              u32x4 w0, w1; w0.x = pk2(o[0], o[1]); w0.y = pk2(o[2], o[3]); w0.z = pk2(o[4], o[5]); w0.w = pk2(o[6], o[7]);
              w1.x = pk2(o[8], o[9]); w1.y = pk2(o[10], o[11]); w1.z = pk2(o[12], o[13]); w1.w = pk2(o[14], o[15]);
              LAS u32x4* d = (LAS u32x4*)(KUt + k * 72 + 16 * qtr); d[0] = w0; d[1] = w1; }
            LDS_BAR();
            { const float bc = bcs[0], dd = __expf(bc); btot += bc;
#pragma unroll
              for (int r = 0; r < 16; ++r) { S0[r] *= dd; S1[r] *= dd; S2[r] *= dd; S3[r] *= dd; }
              mm32<4>(S0, Vt + (32 * w) * 72, 72, KUt, 72, lane); mm32<4>(S1, Vt + (32 * w) * 72, 72, KUt + 32 * 72, 72, lane);
              mm32<4>(S2, Vt + (32 * w) * 72, 72, KUt + 64 * 72, 72, lane); mm32<4>(S3, Vt + (32 * w) * 72, 72, KUt + 96 * 72, 72, lane);
              if (tid < 128) { float s = 0.f; const LAS bf16* kr = KUt + tid * 72;
                  for (int i = 0; i < 64; ++i) s += bf2f(kr[i]);
                  nrun = dd * nrun + s; } }
            LDS_BAR();
        }
        { float* sp = state + (size_t)item * 32768;
#pragma unroll
          for (int r = 0; r < 16; ++r) { float* rp = sp + (32 * w + crow(r, lane >> 5)) * 128 + tl; rp[0] = S0[r]; rp[32] = S1[r]; rp[64] = S2[r]; rp[96] = S3[r]; } }
        if (tid < 128) nst[(size_t)item * 128 + tid] = nrun;
        if (tid == 0) dec[item] = __expf(btot);
    }
}
__device__ __forceinline__ void ml_phaseC(LAS unsigned char* lds, const bf16* proj, const float* gates, const float* state, const float* nst, const float* normg, bf16* mixo, int tid, int G) {
    LAS bf16* Qs = (LAS bf16*)lds;
    LAS bf16* Ks = (LAS bf16*)(lds + 17408);
    LAS bf16* KUt = (LAS bf16*)lds;
    LAS bf16* Vt = (LAS bf16*)(lds + 34816);
    LAS bf16* Cb = (LAS bf16*)(lds + 71680);
    LAS float* bv = (LAS float*)(lds + 141312);
    LAS float* cv = (LAS float*)(lds + 141568);
    LAS float* npv = (LAS float*)(lds + 141824);
    LAS float* red = (LAS float*)(lds + 142336);
    LAS float* lfv = (LAS float*)(lds + 143360);
    LAS float* wsrc = (LAS float*)(lds + 143616);
    LAS float* bcs = (LAS float*)(lds + 143872);
    const int lane = tid & 63, w = tid >> 6, tl = lane & 31, hh = lane >> 5, kx = tid & 127, qtr = tid >> 7;
    for (int item = blockIdx.x; item < 256; item += G) {
        const int sc = item >> 2, hd = item & 3;
        f32x16 S0, S1, S2, S3; float nrun = 0.f;
        { const float* sp = state + (size_t)item * 32768;
#pragma unroll
          for (int r = 0; r < 16; ++r) { const float* rp = sp + (32 * w + crow(r, hh)) * 128 + tl; S0[r] = rp[0]; S1[r] = rp[32]; S2[r] = rp[64]; S3[r] = rp[96]; } }
        if (tid < 128) nrun = nst[(size_t)item * 128 + tid];
#pragma unroll 1
        for (int jc = 0; jc < 4; ++jc) { const int t0 = (sc * 4 + jc) * 64;
            float ig = 0.f;
            if (tid < 64) { lfv[tid] = gates[(size_t)(t0 + tid) * 8 + 4 + hd]; ig = gates[(size_t)(t0 + tid) * 8 + hd]; }
            if (tid < 128) npv[tid] = nrun;
#pragma unroll
            for (int it = 0; it < 2; ++it) { const int idx = it * NTHR + tid, row = idx >> 4, c8 = (idx & 15) * 8; const bf16* src = proj + (size_t)(t0 + row) * 3072 + hd * 128 + c8;
                *(LAS u32x4*)(Qs + row * 136 + c8) = *(const u32x4*)src; *(LAS u32x4*)(Ks + row * 136 + c8) = *(const u32x4*)(src + 512); }
            { const int s = tid & 63, vg = tid >> 6; stage_vt<32>(proj + (size_t)(t0 + s) * 3072 + 1024 + hd * 256 + 32 * vg, Vt + (32 * vg) * 72 + s, 72, true); }
#pragma unroll
            for (int r = 0; r < 16; r += 2) { LAS bf16* d0 = Cb + (32 * w + crow(r, hh)) * 136 + tl;
                const unsigned p0 = pk2(S0[r], S0[r + 1]), p1 = pk2(S1[r], S1[r + 1]), p2_ = pk2(S2[r], S2[r + 1]), p3 = pk2(S3[r], S3[r + 1]);
                d0[0] = (bf16)(p0 & 0xffffu); d0[136] = (bf16)(p0 >> 16); d0[32] = (bf16)(p1 & 0xffffu); d0[136 + 32] = (bf16)(p1 >> 16);
                d0[64] = (bf16)(p2_ & 0xffffu); d0[136 + 64] = (bf16)(p2_ >> 16); d0[96] = (bf16)(p3 & 0xffffu); d0[136 + 96] = (bf16)(p3 >> 16); }
            LDS_BAR();
            if (tid < 64) { float b = 0.f, bc = 0.f;
                for (int s = 0; s < 64; ++s) { const float v = lfv[s]; bc += v; if (s <= tid) b += v; }
                bv[tid] = b; cv[tid] = ig - b; wsrc[tid] = __expf(bc - b + ig) * ML_SCALE; if (tid == 0) bcs[0] = bc; }
            LDS_BAR();
            const int tb = w >> 2, vq = w & 3, t = 32 * tb + tl;
            const float bt = bv[t], ebt = __expf(bt);
            f32x16 ai0, ai1; ZERO16(ai0); ZERO16(ai1);
            mm32<8>(ai0, Cb + (64 * vq) * 136, 136, Qs + (32 * tb) * 136, 136, lane);
            mm32<8>(ai1, Cb + (64 * vq + 32) * 136, 136, Qs + (32 * tb) * 136, 136, lane);
#pragma unroll
            for (int r = 0; r < 16; ++r) { ai0[r] *= ebt; ai1[r] *= ebt; }
            float densum = 0.f;
#pragma unroll
            for (int sb = 0; sb < 2; ++sb) { if (sb <= tb) { f32x16 P; ZERO16(P);
                mm32<8>(P, Ks + (32 * sb) * 136, 136, Qs + (32 * tb) * 136, 136, lane);
#pragma unroll
                for (int r = 0; r < 16; ++r) { const int s = 32 * sb + crow(r, hh); const float wg = (s <= t) ? __expf(bt + cv[s]) : 0.f; const float v = P[r] * ML_SCALE * wg; densum += v; P[r] = v; }
                const LAS bf16* vr0 = Vt + (64 * vq + tl) * 72 + 32 * sb; const LAS bf16* vr1 = vr0 + 32 * 72;
                mm_accop(ai0, vr0, P, 0, hh); mm_accop(ai0, vr0, P, 1, hh); mm_accop(ai1, vr1, P, 0, hh); mm_accop(ai1, vr1, P, 1, hh); } }
            densum += __shfl_xor(densum, 32);
            float qn = 0.f;
            { const LAS bf16* qr = Qs + t * 136 + 64 * hh; const LAS float* np = npv + 64 * hh;
#pragma unroll 8
              for (int i = 0; i < 64; ++i) qn += bf2f(qr[i]) * np[i]; }
            qn += __shfl_xor(qn, 32);
            const float den = densum + ebt * qn; const float inv = 1.0f / fmaxf(fabsf(den), 1.0f);
            float ssq = 0.f;
#pragma unroll
            for (int r = 0; r < 16; ++r) { ai0[r] *= inv; ai1[r] *= inv; ssq += ai0[r] * ai0[r] + ai1[r] * ai1[r]; }
            ssq += __shfl_xor(ssq, 32);
            if (lane < 32) red[vq * 64 + t] = ssq;
            unsigned kraw[16];
#pragma unroll
            for (int i = 0; i < 16; ++i) kraw[i] = Ks[(16 * qtr + i) * 136 + kx];
            LDS_BAR();
            { float o[16];
#pragma unroll
              for (int i = 0; i < 16; ++i) o[i] = bf2f(kraw[i]) * wsrc[16 * qtr + i];
              u32x4 w0, w1; w0.x = pk2(o[0], o[1]); w0.y = pk2(o[2], o[3]); w0.z = pk2(o[4], o[5]); w0.w = pk2(o[6], o[7]);
              w1.x = pk2(o[8], o[9]); w1.y = pk2(o[10], o[11]); w1.z = pk2(o[12], o[13]); w1.w = pk2(o[14], o[15]);
              LAS u32x4* d = (LAS u32x4*)(KUt + kx * 72 + 16 * qtr); d[0] = w0; d[1] = w1; }
            { const float tot = (red[t] + red[64 + t]) + (red[128 + t] + red[192 + t]); const float rms = __builtin_amdgcn_rsqf(tot * (1.0f / 256.0f) + EPS);
              const bf16* ogp = proj + (size_t)(t0 + t) * 3072 + 2048 + hd * 256; bf16* op = mixo + (size_t)(t0 + t) * 1024 + hd * 256; const float* gp = normg + hd * 256;
#pragma unroll
              for (int vt2 = 0; vt2 < 2; ++vt2)
#pragma unroll
                for (int g = 0; g < 4; ++g) { const int v0 = 64 * vq + 32 * vt2 + 8 * g + 4 * hh; const u32x2 ow = *(const u32x2*)(ogp + v0); const f32x4 gn = *(const f32x4*)(gp + v0);
                  const float a0 = vt2 ? ai1[4 * g + 0] : ai0[4 * g + 0], a1 = vt2 ? ai1[4 * g + 1] : ai0[4 * g + 1], a2 = vt2 ? ai1[4 * g + 2] : ai0[4 * g + 2], a3 = vt2 ? ai1[4 * g + 3] : ai0[4 * g + 3];
                  u32x2 o; o.x = pk2(a0 * rms * gn[0] * sigmoidf_(bflo(ow.x)), a1 * rms * gn[1] * sigmoidf_(bfhi(ow.x)));
                  o.y = pk2(a2 * rms * gn[2] * sigmoidf_(bflo(ow.y)), a3 * rms * gn[3] * sigmoidf_(bfhi(ow.y))); *(u32x2*)(op + v0) = o; } }
            LDS_BAR();
            { const float dd = __expf(bcs[0]);
#pragma unroll
              for (int r = 0; r < 16; ++r) { S0[r] *= dd; S1[r] *= dd; S2[r] *= dd; S3[r] *= dd; }
              mm32<4>(S0, Vt + (32 * w) * 72, 72, KUt, 72, lane); mm32<4>(S1, Vt + (32 * w) * 72, 72, KUt + 32 * 72, 72, lane);
              mm32<4>(S2, Vt + (32 * w) * 72, 72, KUt + 64 * 72, 72, lane); mm32<4>(S3, Vt + (32 * w) * 72, 72, KUt + 96 * 72, 72, lane);
              if (tid < 128) { float s = 0.f; const LAS bf16* kr = KUt + tid * 72;
                  for (int i = 0; i < 64; ++i) s += bf2f(kr[i]);
                  nrun = dd * nrun + s; } }
            LDS_BAR();
        }
    }
}

__device__ __forceinline__ void swa_phase(LAS unsigned char* lds, const bf16* proj, const float* qg, const float* kg, const float* sinks, bf16* mixo, int tid, int G) {
    LAS bf16* Ks = (LAS bf16*)lds;
    LAS bf16* Vt = (LAS bf16*)(lds + 36864);
    LAS bf16* Qs = (LAS bf16*)(lds + 70656);
    const int lane = tid & 63, w = tid >> 6, tl = lane & 31, hh = lane >> 5;
    for (int item = blockIdx.x; item < 512; item += G) {
        const int nb = item >> 2, kvh = item & 3, tok0 = 128 * nb - 128;
        { const int c = tid & 7, r0 = tid >> 3;
          const f32x4 kg0 = *(const f32x4*)(kg + 8 * c), kg1 = *(const f32x4*)(kg + 8 * c + 4), qg0 = *(const f32x4*)(qg + 8 * c), qg1 = *(const f32x4*)(qg + 8 * c + 4);
#pragma unroll 2
          for (int pass = 0; pass < 12; ++pass) { const bool isk = pass < 4; const int row = r0 + 64 * (isk ? pass : pass - 4);
              int tok; const bf16* src;
              if (isk) { tok = tok0 + row; src = proj + (size_t)tok * 1536 + 1024 + kvh * 64 + 8 * c; }
              else { tok = 128 * nb + (row & 127); src = proj + (size_t)tok * 1536 + (kvh * 4 + (row >> 7)) * 64 + 8 * c; }
              u32x4 v = (tok >= 0) ? *(const u32x4*)src : (u32x4){0u, 0u, 0u, 0u};
              float f[8] = {bflo(v.x), bfhi(v.x), bflo(v.y), bfhi(v.y), bflo(v.z), bfhi(v.z), bflo(v.w), bfhi(v.w)};
              float ss = 0.f;
#pragma unroll
              for (int j = 0; j < 8; ++j) ss += f[j] * f[j];
              ss += __shfl_xor(ss, 1); ss += __shfl_xor(ss, 2); ss += __shfl_xor(ss, 4);
              const float r = __builtin_amdgcn_rsqf(ss * (1.0f / 64.0f) + EPS);
              const f32x4 g0 = isk ? kg0 : qg0, g1 = isk ? kg1 : qg1;
              u32x4 o; o.x = pk2(f[0] * r * g0[0], f[1] * r * g0[1]); o.y = pk2(f[2] * r * g0[2], f[3] * r * g0[3]); o.z = pk2(f[4] * r * g1[0], f[5] * r * g1[1]); o.w = pk2(f[6] * r * g1[2], f[7] * r * g1[3]);
              *(LAS u32x4*)((isk ? Ks : Qs) + row * 72 + 8 * c) = o; } }
        { const int s = tid & 255, dg = tid >> 8, tok = tok0 + s;
          stage_vt<32>(proj + (size_t)tok * 1536 + 1280 + kvh * 64 + 32 * dg, Vt + (32 * dg) * 264 + s, 264, tok >= 0); }
        LDS_BAR();
#pragma unroll 1
        for (int rep = 0; rep < 2; ++rep) { const int task = w + 8 * rep, g = task >> 2, qb = task & 3, hq = kvh * 4 + g, tq = 32 * qb + tl;
            const float slope = exp2f(-0.5f * (float)(hq + 1)), sink = sinks[hq];
            const int dbase = tl - 4 * hh; const unsigned dmax = (nb == 0) ? (unsigned)(tq + 1) : 128u;
            const LAS bf16* qrow = Qs + (g * 128 + 32 * qb) * 72; const LAS bf16* krow = Ks + (32 * qb) * 72;
            float m = sink;
#pragma unroll 1
            for (int kb = 0; kb < 5; ++kb) { f32x16 S; ZERO16(S); mm32<4>(S, krow + (32 * kb) * 72, 72, qrow, 72, lane);
                const int db = dbase + 128 - 32 * kb;
#pragma unroll
                for (int r = 0; r < 16; ++r) { const int dist = db - ((r & 3) + 8 * (r >> 2)); const float sc = S[r] * 0.125f - slope * (float)dist; if ((unsigned)dist < dmax) m = fmaxf(m, sc); } }
            m = fmaxf(m, __shfl_xor(m, 32));
            float l = 0.f; f32x16 O0, O1; ZERO16(O0); ZERO16(O1);
#pragma unroll 1
            for (int kb = 0; kb < 5; ++kb) { f32x16 S; ZERO16(S); mm32<4>(S, krow + (32 * kb) * 72, 72, qrow, 72, lane);
                const int db = dbase + 128 - 32 * kb;
#pragma unroll
                for (int r = 0; r < 16; ++r) { const int dist = db - ((r & 3) + 8 * (r >> 2)); const float sc = S[r] * 0.125f - slope * (float)dist; const float p = ((unsigned)dist < dmax) ? __expf(sc - m) : 0.f; S[r] = p; l += p; }
                const LAS bf16* vr0 = Vt + tl * 264 + 32 * qb + 32 * kb; const LAS bf16* vr1 = vr0 + 32 * 264;
                mm_accop(O0, vr0, S, 0, hh); mm_accop(O0, vr0, S, 1, hh); mm_accop(O1, vr1, S, 0, hh); mm_accop(O1, vr1, S, 1, hh); }
            l += __shfl_xor(l, 32); l += __expf(sink - m);
            const float inv = 1.0f / l; bf16* op = mixo + (size_t)(128 * nb + tq) * 1024 + hq * 64;
#pragma unroll
            for (int gq = 0; gq < 4; ++gq) { const int d0 = 8 * gq + 4 * hh; u32x2 o;
                o.x = pk2(O0[4 * gq] * inv, O0[4 * gq + 1] * inv); o.y = pk2(O0[4 * gq + 2] * inv, O0[4 * gq + 3] * inv); *(u32x2*)(op + d0) = o;
                o.x = pk2(O1[4 * gq] * inv, O1[4 * gq + 1] * inv); o.y = pk2(O1[4 * gq + 2] * inv, O1[4 * gq + 3] * inv); *(u32x2*)(op + 32 + d0) = o; } }
        LDS_BAR();
    }
}

#ifndef REP_GU
#define REP_GU 1
#endif
#ifndef REP_PRO
#define REP_PRO 1
#endif
#ifndef REP_SYNC
#define REP_SYNC 1
#endif
#ifndef REP_MIX
#define REP_MIX 1
#endif
#ifndef MK_PER_PHASE_LAUNCH
#define MK_PER_PHASE_LAUNCH 0
#endif
__global__ void __launch_bounds__(NTHR, 2) fwd(Args a) {
    extern __shared__ __attribute__((aligned(16))) unsigned char lds_raw[];
    LAS unsigned char* lds = (LAS unsigned char*)lds_raw;
    const int G0 = gridDim.x;
    if (threadIdx.x < 16) ((LAS unsigned*)(lds + LDS_BARST))[threadIdx.x] = 0u;
    __syncthreads();
    const XcdBarrier bar = xcd_barrier_post((unsigned*)(a.ws + WS_BAR), (volatile LAS unsigned*)(lds + LDS_BARST));
    if (threadIdx.x == 0) ((unsigned*)(a.ws + WS_BAR))[XB_MAP + blockIdx.x] = bar.x;
    const int ph_hi = a.ph_hi;
    if (a.ph_lo == 0) {
#ifndef DIS_PRO
#pragma unroll 1
        for (int rr = 0; rr < REP_PRO; ++rr) prologue(a, lds, (int)threadIdx.x, G0);
#endif
        if (1 < ph_hi) { xcd_barrier(bar); } }
    if (ph_hi < 0) cg::this_grid().sync();
    int local_ok = 0;
    if (a.ph_lo == 0 && G0 == 256) {
        if (threadIdx.x == 0) { unsigned* xm = (unsigned*)(a.ws + WS_BAR) + XB_MAP; unsigned ok = 1u, seen = 0u;
            for (int b = 0; b < 8; ++b) { const unsigned x = xb_ld(xm + b); if (x > 15u || ((seen >> x) & 1u)) ok = 0u; seen |= 1u << (x & 15u); }
            for (int b = 8; b < 256; ++b) { if (xb_ld(xm + b) != xb_ld(xm + (b & 7))) ok = 0u; }
            ((volatile LAS unsigned*)(lds + LDS_BARST))[4] = ok; }
        __syncthreads();
        local_ok = (int)__builtin_amdgcn_readfirstlane(((volatile LAS unsigned*)(lds + LDS_BARST))[4]); }
    unsigned char* const ws0 = a.ws; float* const out0 = a.out;
    for (int p = (a.ph_lo > 1 ? a.ph_lo : 1); p < ph_hi; ++p) {
        int tid = threadIdx.x; asm volatile("" : "+v"(tid));
        int G = G0; asm volatile("" : "+s"(G));
        int bid = blockIdx.x; asm volatile("" : "+s"(bid));
        size_t zoff = 0; asm volatile("" : "+s"(zoff));
        unsigned char* ws = ws0 + zoff; float* OUT = out0 + zoff;
        ss_t* SS = (ss_t*)(ws + WS_SS);
        bf16* ACT = (bf16*)(ws + WS_ACT); bf16* PROJ = (bf16*)(ws + WS_PROJ); bf16* MIXO = (bf16*)(ws + WS_MIXO); bf16* PPb = (bf16*)(ws + WS_PP);
        float* STATE = (float*)(ws + WS_STATE); float* DEC = (float*)(ws + WS_DEC); float* NST = (float*)(ws + WS_NST); float* GATES = (float*)(ws + WS_GATES);
        const float* PAR = (const float*)(ws + WS_PAR);
        int layer = 0, step = 0;
        { const int q = p - 1;
            if (q < 10) { layer = 0; step = q; } else if (q < 20) { layer = 1; step = q - 10; }
            else if (q < 28) { layer = 2; step = q - 20; if (step >= 3) step = (step == 3) ? 10 : step + 2; } else { layer = 3; step = q - 28; } }
        const int kind = layer % 3, j = layer / 3;
        bf16* xb_in = (bf16*)(ws + ((layer & 1) ? WS_XB1 : WS_XB0)); bf16* xb_out = (bf16*)(ws + ((layer & 1) ? WS_XB0 : WS_XB1));
        if (step == 0 || step == 7) { const int sub = (step == 7) ? 1 : 0;
            pg8::Gemm g{xb_in, (const bf16*)(ws + WS_WGU) + (size_t)(layer * 2 + sub) * 2 * FF * D, T, 2 * FF, D}; pg8::StaticOrder S; S.init(T, 2 * FF, G, bid);
            pg8::EpiSwiGLU E{ACT, FF, SS + (size_t)(layer * 4 + sub * 2) * T};

#ifndef DIS_GU
#pragma unroll 1
 for (int rr = 0; rr < REP_GU; ++rr) pg8::gemm_phase<pg8::EpiSwiGLU, pg8::StaticOrder, true, true>(lds, g, S, E);
#endif
            if (step == 0 && G == 256 && bid >= 128) {
                pg8::Gemm g2{(const bf16*)(ws + WS_PB) + (size_t)layer * T * PLE_DIM, (const bf16*)(ws + WS_WPP) + (size_t)layer * D * PLE_DIM, T, D, PLE_DIM}; pg8::EpiRsBf16 E2{PPb, D, nullptr};
                pg8::StaticOrder S2; S2.init(T, D, 128, bid - 128);
                pg8::gemm_phase<pg8::EpiRsBf16, pg8::StaticOrder, true, true>(lds, g2, S2, E2); }
 }
        else if (step == 1 || step == 8 || step == 6) {
            pg8::Gemm g; pg8::EpiResid<false> E; E.out = nullptr; E.xb = xb_in; E.ss_in = nullptr; E.pp = nullptr; E.base = xb_in;
            if (step == 6) { const bf16* wo = (kind == 0) ? (const bf16*)(ws + WS_HGOUT) + (size_t)j * D * D : (kind == 1) ? (const bf16*)(ws + WS_MLOUT) : (const bf16*)(ws + WS_SWOUT);
                g = pg8::Gemm{MIXO, wo, T, D, D}; E.alpha = 1.0f; E.ss_out = SS + (size_t)(layer * 4 + 2) * T; }
            else { const int sub = (step == 8) ? 1 : 0; g = pg8::Gemm{ACT, (const bf16*)(ws + WS_WDN) + (size_t)(layer * 2 + sub) * D * FF, T, D, FF}; E.alpha = 0.5f;
                E.ss_out = SS + (size_t)(layer * 4 + 1 + 2 * sub) * T; }
            pg8::StaticOrder S; S.init(T, D, G, bid);

#ifndef DIS_RES
 pg8::gemm_phase<pg8::EpiResid<false>, pg8::StaticOrder, true, true>(lds, g, S, E);
#endif
 }
        else if (step == 2) {
#pragma unroll 1
            for (int rep = 0; rep < (G == 256 ? 1 : 2); ++rep) { pg8::Gemm g; pg8::EpiRsBf16 E;
                if (rep == 0) { const int N = (kind == 0) ? 4 * D : (kind == 1) ? 3 * D : 1536;
                    const bf16* wi = (kind == 0) ? (const bf16*)(ws + WS_HGIN) + (size_t)j * 4 * D * D : (kind == 1) ? (const bf16*)(ws + WS_MLIN) : (const bf16*)(ws + WS_SWIN);
                    g = pg8::Gemm{xb_in, wi, T, N, D}; E = pg8::EpiRsBf16{PROJ, N, SS + (size_t)(layer * 4 + 1) * T}; }
                else { g = pg8::Gemm{(const bf16*)(ws + WS_PB) + (size_t)layer * T * PLE_DIM, (const bf16*)(ws + WS_WPP) + (size_t)layer * D * PLE_DIM, T, D, PLE_DIM}; E = pg8::EpiRsBf16{PPb, D, nullptr}; }
                pg8::StaticOrder S; S.init(T, g.N, G, bid);

#ifndef DIS_RS
 pg8::gemm_phase<pg8::EpiRsBf16, pg8::StaticOrder, true, true>(lds, g, S, E);
#endif
 }

#ifndef DIS_GATES
 if (kind == 1) ml_gates(lds, xb_in, SS + (size_t)(layer * 4 + 1) * T, (const float*)(ws + WS_WIF), PAR + 256, GATES, tid, G);
#endif
 }
        else if (step == 3) {
#ifndef DIS_A
#pragma unroll 1
 for (int rr = 0; rr < REP_MIX; ++rr)
 if (kind == 0) hg_phaseA(lds, PROJ, (const float*)(ws + WS_LB) + j * D, STATE, DEC, tid, G); else ml_phaseA(lds, PROJ, GATES, STATE, DEC, NST, tid, G);
#endif
 }
        else if (step == 4) {
#ifndef DIS_SCAN
 scan_phase(STATE, DEC, kind == 1 ? 1 : 0, NST, kind == 1 ? 64 : 32, tid, G);
#endif
 }
        else if (step == 5) {
#ifndef DIS_HGC
#pragma unroll 1
 for (int rr = 0; rr < REP_MIX; ++rr)
 if (kind == 0) hg_phaseC(lds, PROJ, (const float*)(ws + WS_LB) + j * D, STATE, PAR + j * 128, MIXO, tid, G);
#endif
#ifndef DIS_MLC
#pragma unroll 1
 for (int rr = 0; rr < REP_MIX; ++rr)
 if (kind == 1) ml_phaseC(lds, PROJ, GATES, STATE, NST, PAR + 512, MIXO, tid, G);
#endif
 }
        else if (step == 10) {
#ifndef DIS_SWA
#pragma unroll 1
 for (int rr = 0; rr < REP_MIX; ++rr)
 swa_phase(lds, PROJ, PAR + 1536, PAR + 1600, PAR + 1664, MIXO, tid, G);
#endif
 }
        else if (step == 9) {
            pg8::Gemm g{xb_in, (const bf16*)(ws + WS_WPG) + (size_t)layer * D * D, T, D, D}; pg8::StaticOrder S; S.init(T, D, G, bid);
            pg8::EpiResid<true> E; E.base = xb_in; E.out = (layer == 3) ? OUT : nullptr; E.xb = xb_out; E.ss_out = SS + (size_t)((layer + 1) * 4) * T; E.alpha = 1.0f; E.ss_in = SS + (size_t)(layer * 4 + 3) * T; E.pp = PPb;

#ifndef DIS_PLE
 pg8::gemm_phase<pg8::EpiResid<true>, pg8::StaticOrder, true, true>(lds, g, S, E);
#endif
 }
        if (p + 1 < ph_hi) {
#pragma unroll 1
            for (int rr = 0; rr < REP_SYNC; ++rr) { if (local_ok && (step == 0 || step == 1 || step == 6 || step == 7 || step == 8 || step == 9)) xcd_barrier_local(bar); else xcd_barrier(bar); } }
    }
}

extern "C" void kernel_launch(void* const* d_in, const int* in_sizes, int n_in, void* d_out, int out_size, void* d_ws, size_t ws_size, hipStream_t stream) {
    static int grid = 0;
    if (grid == 0) {
        if (n_in != 21 || in_sizes[0] != T * D || out_size != T * D || ws_size < WS_END) { fprintf(stderr, "kernel_launch: unexpected problem (n_in %d, in0 %d, out %d, ws %zu; need ws >= %zu)\n", n_in, n_in > 0 ? in_sizes[0] : -1, out_size, ws_size, (size_t)WS_END); grid = -1; return; }
        int dev = 0, cus = 0, per_cu = 0;
        if (hipGetDevice(&dev) != hipSuccess || hipDeviceGetAttribute(&cus, hipDeviceAttributeMultiprocessorCount, dev) != hipSuccess) { fprintf(stderr, "kernel_launch: device query failed\n"); grid = -1; return; }
        if (hipFuncSetAttribute((const void*)fwd, hipFuncAttributeMaxDynamicSharedMemorySize, LDS_BYTES) != hipSuccess) { fprintf(stderr, "kernel_launch: hipFuncSetAttribute failed\n"); grid = -1; return; }
        if (hipOccupancyMaxActiveBlocksPerMultiprocessor(&per_cu, (const void*)fwd, NTHR, LDS_BYTES) != hipSuccess || per_cu < 1) { fprintf(stderr, "kernel_launch: occupancy query gave %d\n", per_cu); per_cu = 1; }
        (void)hipGetLastError();
        grid = cus;
    }
    if (grid < 0) return;
    (void)hipMemsetAsync((char*)d_ws + WS_BAR, 0, 16384, stream);
    Args a{};
    for (int i = 0; i < 21; ++i) a.in[i] = (const float*)d_in[i];
    a.out = (float*)d_out; a.ws = (unsigned char*)d_ws;
#if MK_PER_PHASE_LAUNCH
    for (int p = 0; p < NPHASE; ++p) { a.ph_lo = p; a.ph_hi = p + 1; hipLaunchKernelGGL(fwd, dim3(grid), dim3(NTHR), LDS_BYTES, stream, a); }
#else
    a.ph_lo = 0; a.ph_hi = NPHASE;
    void* args[] = {&a};
    const hipError_t e = hipLaunchCooperativeKernel((const void*)fwd, dim3(grid), dim3(NTHR), args, LDS_BYTES, stream);
    if (e != hipSuccess) fprintf(stderr, "kernel_launch: cooperative launch failed: %s (grid %d)\n", hipGetErrorString(e), grid);
#endif
}
```
